# Optimizing an MI355X kernel written in HIP

```python
import math
import jax, jax.numpy as jnp
from jax import lax
import numpy as np

D_MODEL = 4096
BATCH = 1
SEQ = 8192
DEPTH = 1

CHUNK = 64
W_A = 4096
H_A = 16
BW_A = W_A // H_A
CONV_W = 4
LRU_C = 8.0
W_B = 4096
G_B = 16
DG_B = W_B // G_B
SPATIAL = 128
MIX = W_A + W_B
IN_COLS = 2 * W_A + 3 * W_B
EPS = 1e-6

kernel_name = "hybrid_rglru_gmlp_parallel_heads"


def rmsnorm(x, g):
    xf = x.astype(jnp.float32)
    y = xf * lax.rsqrt(jnp.mean(xf * xf, axis=-1, keepdims=True) + EPS)
    return (y * g.astype(jnp.float32)).astype(x.dtype)


def layernorm_f32(x, g, b):
    xf = x.astype(jnp.float32)
    mu = jnp.mean(xf, axis=-1, keepdims=True)
    var = jnp.mean(jnp.square(xf - mu), axis=-1, keepdims=True)
    return (xf - mu) * lax.rsqrt(var + EPS) * g.astype(jnp.float32) + b.astype(jnp.float32)


def causal_depthwise_conv(x, w, b):
    S = x.shape[1]
    xp = jnp.pad(x, ((0, 0), (CONV_W - 1, 0), (0, 0)))
    y = b
    for k in range(CONV_W):
        y = y + xp[:, k:k + S, :] * w[k]
    return y


def rg_lru(x, w_a, b_a, w_x, b_x, lam):
    B, S, _ = x.shape
    xh = x.reshape(B, S, H_A, BW_A)
    r = jax.nn.sigmoid(jnp.einsum('bshi,hij->bshj', xh, w_a) + b_a).reshape(B, S, W_A)
    i = jax.nn.sigmoid(jnp.einsum('bshi,hij->bshj', xh, w_x) + b_x).reshape(B, S, W_A)
    log_a = -LRU_C * r.astype(jnp.float32) * jax.nn.softplus(-lam.astype(jnp.float32))
    a = jnp.exp(log_a)
    inp = jnp.sqrt(-jnp.expm1(2.0 * log_a)) * (i.astype(jnp.float32) * x.astype(jnp.float32))

    def combine(left, right):
        a_l, b_l = left
        a_r, b_r = right
        return a_l * a_r, a_r * b_l + b_r

    _, h = lax.associative_scan(combine, (a, inp), axis=1)
    return h.astype(x.dtype)


def spatial_gating(u, v, ln_g, ln_b, w_sp, b_sp):
    B, S, _ = v.shape
    n = S // SPATIAL
    vn = layernorm_f32(v, ln_g, ln_b).reshape(B, n, SPATIAL, G_B, DG_B)
    blk = jnp.arange(SPATIAL) // CHUNK
    mask = (blk[None, :] <= blk[:, None]).astype(jnp.float32)
    ws = w_sp.astype(jnp.float32) * mask
    s = jnp.einsum('gij,bnjgd->bnigd', ws, vn) + b_sp.astype(jnp.float32).T[None, None, :, :, None]
    return (u.astype(jnp.float32) * s.reshape(B, S, W_B)).astype(u.dtype)


def setup_inputs(seed: int = 0) -> dict:
    key = jax.random.key(seed)
    ks = jax.random.split(key, 16)
    f32 = jnp.float32
    x = jax.random.normal(ks[0], (BATCH, SEQ, D_MODEL), f32)
    norm_g = 1.0 + 0.1 * jax.random.normal(ks[1], (DEPTH, D_MODEL), f32)
    w_in = jax.random.normal(ks[2], (DEPTH, D_MODEL, IN_COLS), f32) * D_MODEL ** -0.5
    conv_w = jax.random.normal(ks[3], (DEPTH, CONV_W, W_A), f32) * CONV_W ** -0.5
    conv_b = 0.01 * jax.random.normal(ks[4], (DEPTH, W_A), f32)
    w_gate_a = jax.random.normal(ks[5], (DEPTH, H_A, BW_A, BW_A), f32) * BW_A ** -0.5
    b_gate_a = 0.01 * jax.random.normal(ks[6], (DEPTH, H_A, BW_A), f32)
    w_gate_x = jax.random.normal(ks[7], (DEPTH, H_A, BW_A, BW_A), f32) * BW_A ** -0.5
    b_gate_x = 0.01 * jax.random.normal(ks[8], (DEPTH, H_A, BW_A), f32)
    u0 = jax.random.uniform(ks[9], (DEPTH, W_A), f32, minval=0.9, maxval=0.999)
    a0 = u0 ** (1.0 / LRU_C)
    lru_lambda = jnp.log(a0) - jnp.log1p(-a0)
    ln_v_g = 1.0 + 0.1 * jax.random.normal(ks[10], (DEPTH, W_B), f32)
    ln_v_b = 0.01 * jax.random.normal(ks[11], (DEPTH, W_B), f32)
    w_spatial = 0.5 * jax.random.normal(ks[12], (DEPTH, G_B, SPATIAL, SPATIAL), f32) * SPATIAL ** -0.5
    b_spatial = 1.0 + 0.1 * jax.random.normal(ks[13], (DEPTH, G_B, SPATIAL), f32)
    w_out = jax.random.normal(ks[14], (DEPTH, MIX, D_MODEL), f32) * MIX ** -0.5
    final_g = 1.0 + 0.1 * jax.random.normal(ks[15], (D_MODEL,), f32)
    return {"x": x, "norm_g": norm_g, "w_in": w_in, "conv_w": conv_w, "conv_b": conv_b,
            "w_gate_a": w_gate_a, "b_gate_a": b_gate_a, "w_gate_x": w_gate_x, "b_gate_x": b_gate_x,
            "lru_lambda": lru_lambda, "ln_v_g": ln_v_g, "ln_v_b": ln_v_b,
            "w_spatial": w_spatial, "b_spatial": b_spatial, "w_out": w_out, "final_g": final_g}


def reference(x, norm_g, w_in, conv_w, conv_b, w_gate_a, b_gate_a, w_gate_x, b_gate_x,
              lru_lambda, ln_v_g, ln_v_b, w_spatial, b_spatial, w_out, final_g):
    for l in range(DEPTH):
        hn = rmsnorm(x, norm_g[l])
        proj = jnp.einsum('bsd,de->bse', hn, w_in[l])
        xa, ga, u, v, gb = jnp.split(proj, [W_A, 2 * W_A, 2 * W_A + W_B, 2 * W_A + 2 * W_B], axis=-1)
        xa = causal_depthwise_conv(xa, conv_w[l], conv_b[l])
        ya = rg_lru(xa, w_gate_a[l], b_gate_a[l], w_gate_x[l], b_gate_x[l], lru_lambda[l])
        yb = spatial_gating(jax.nn.gelu(u, approximate=False), jax.nn.gelu(v, approximate=False),
                            ln_v_g[l], ln_v_b[l], w_spatial[l], b_spatial[l])
        mixed = jnp.concatenate([ya * jax.nn.silu(ga), yb * jax.nn.silu(gb)], axis=-1)
        x = x + jnp.einsum('bse,ed->bsd', mixed, w_out[l])
    return rmsnorm(x, final_g)
```

```cpp
#include <hip/hip_runtime.h>
#include <hip/hip_cooperative_groups.h>
#include <cstdio>
namespace cg = cooperative_groups;

#define LAS __attribute__((address_space(3)))
typedef unsigned short bf16_t;
typedef short bf16x8 __attribute__((ext_vector_type(8)));
typedef float f32x4 __attribute__((ext_vector_type(4)));
typedef float f32x2 __attribute__((ext_vector_type(2)));
typedef unsigned u32x4 __attribute__((ext_vector_type(4)));
typedef unsigned u32x2 __attribute__((ext_vector_type(2)));

constexpr int SEQ = 8192, DM = 4096, INC = 20480, MIXW = 8192, WA = 4096, WB = 4096;
constexpr int NTHREADS = 512, NWAVES = 8;
constexpr int LDS_BYTES = 136 * 1024;
constexpr float EPS = 1e-6f;

constexpr size_t WS_WINT = 0;
constexpr size_t WS_WOUTT = WS_WINT + (size_t)INC * DM * 2;
constexpr size_t WS_WGT = WS_WOUTT + (size_t)DM * MIXW * 2;
constexpr size_t WS_WSP = WS_WGT + (size_t)32 * 256 * 256 * 2;
constexpr size_t WS_SP8 = WS_WSP + (size_t)16 * 128 * 128 * 2;
constexpr size_t WS_HN = WS_SP8 + (size_t)4096 * 4;
constexpr size_t WS_PROJ = WS_HN + (size_t)SEQ * DM * 2;
constexpr size_t WS_XC = WS_PROJ + (size_t)SEQ * INC * 2;
constexpr size_t WS_LNS = WS_XC + (size_t)SEQ * WA * 2;
constexpr size_t WS_STAT = WS_LNS + (size_t)SEQ * 64 * 2 * 4;
constexpr size_t WS_LOGA = WS_STAT + (size_t)SEQ * 2 * 4;
constexpr size_t WS_INP = WS_LOGA + (size_t)SEQ * WA * 2;
constexpr size_t WS_MIXED = WS_INP + (size_t)SEQ * WA * 2;
constexpr size_t WS_P = WS_MIXED + (size_t)SEQ * MIXW * 2;
constexpr size_t WS_HEND = WS_P + (size_t)64 * 4096 * 4;
constexpr size_t WS_SS = WS_HEND + (size_t)64 * 4096 * 4;
constexpr size_t WS_BAR = WS_SS + (size_t)SEQ * 64 * 4;
constexpr size_t BAR_BYTES = 65536;
constexpr size_t WS_END = WS_BAR + BAR_BYTES;

constexpr size_t SEGE = (size_t)SEQ * 4096;
constexpr size_t OFF_XA = 0, OFF_GA = SEGE, OFF_U = 2 * SEGE, OFF_V = 3 * SEGE, OFF_GB = 4 * SEGE;
struct Params {
    const float *x, *norm_g, *w_in, *conv_w, *conv_b, *w_gate_a, *b_gate_a, *w_gate_x, *b_gate_x, *lru_lambda, *ln_v_g, *ln_v_b, *w_spatial, *b_spatial, *w_out, *final_g;
    float* out; unsigned char* ws;
    int ph_lo, ph_hi;
};

__device__ __forceinline__ unsigned pk2(float lo, float hi) { unsigned r; asm("v_cvt_pk_bf16_f32 %0, %1, %2" : "=v"(r) : "v"(lo), "v"(hi)); return r; }
__device__ __forceinline__ float bflo(unsigned w) { return __uint_as_float(w << 16); }
__device__ __forceinline__ float bfhi(unsigned w) { return __uint_as_float(w & 0xffff0000u); }
__device__ __forceinline__ float wave_sum(float v) {
#pragma unroll
    for (int o = 1; o < 64; o <<= 1) v += __shfl_xor(v, o);
    return v;
}
__device__ __forceinline__ float fast_sigmoid(float x) { return __builtin_amdgcn_rcpf(1.0f + __builtin_amdgcn_exp2f(-1.4426950408889634f * x)); }
__device__ __forceinline__ float silu_f(float x) { return x * fast_sigmoid(x); }
__device__ __forceinline__ f32x2 gelu_pk(f32x2 v) {
    const f32x2 av = __builtin_elementwise_abs(v), d = av * 0.2316418882f + 1.0f;
    f32x2 t; t.x = __builtin_amdgcn_rcpf(d.x); t.y = __builtin_amdgcn_rcpf(d.y);
    f32x2 q = t * 0.5307027145f + (-0.7265760135f); q = q * t + 0.7107068705f; q = q * t + (-0.142248368f); q = q * t + 0.127414796f; q = q * t;
    const f32x2 s = (v * v) * (-0.72134752044f);
    f32x2 e; e.x = __builtin_amdgcn_exp2f(s.x); e.y = __builtin_amdgcn_exp2f(s.y);
    const f32x2 m = v * (q * e), r = v - m;
    f32x2 o; o.x = v.x < 0.f ? m.x : r.x; o.y = v.y < 0.f ? m.y : r.y; return o;
}
#define LDS_WAIT() asm volatile("s_waitcnt lgkmcnt(0)" ::: "memory")

namespace pg8 {
constexpr int BM = 256, BK = 64, HALF = 128, HTB = HALF * BK * 2, STAGE_BYTES = 8 * HTB, NXCD = 8, WGM = 8;
__host__ __device__ __forceinline__ int lds_byte(int r, int c) { const int st = (r >> 4) * 2 + (c >> 5), rr = r & 15, cc = c & 31, ob = rr * 64 + cc * 2; return st * 1024 + (ob ^ (((ob >> 9) & 1) << 5)); }
__host__ __device__ __forceinline__ void stage_rc(int b, int& R, int& C) { const int st = b / 1024, sb = b % 1024, swz = sb ^ (((sb >> 9) & 1) << 5); R = (st >> 1) * 16 + swz / 64; C = (st & 1) * 32 + (swz % 64) / 2; }
__host__ __device__ __forceinline__ int perm32(int rho) { const int n = rho >> 4, i = rho & 15; return 8 * (i >> 2) + 4 * n + (i & 3); }
struct Unit { int pm, pn; };
struct StaticOrder {
    int nM, nN, nwg, G, c;
    __device__ void init(int nM_, int nN_, int G_, int c_) { nM = nM_; nN = nN_; nwg = nM * nN; G = G_; c = c_; }
    __device__ bool next(int i, Unit& u) const {
        const long L = (long)i * G + c; if (L >= nwg) return false;
        int wgid = (int)L; { const int q = nwg / NXCD, r = nwg % NXCD, xcd = wgid % NXCD, off = wgid / NXCD; wgid = (xcd < r ? xcd * (q + 1) : r * (q + 1) + (xcd - r) * q) + off; }
        const int nig = WGM * nN, gid = wgid / nig, fm = gid * WGM, gsz = (nM - fm) < WGM ? (nM - fm) : WGM;
        u.pm = fm + ((wgid % nig) % gsz); u.pn = (wgid % nig) / gsz; return true;
    }
};

template <bool PERM, class Prob, class Order, class Epi>
__device__ __forceinline__ void gemm_phase(LAS unsigned char* lds, const Prob& P, const Order& S, const Epi& E) {
    const int tid = threadIdx.x, wid = __builtin_amdgcn_readfirstlane(tid >> 6), lane = tid & 63, wr = wid >> 2, wc = wid & 3, fr = lane & 15, fq = lane >> 4;
    const int nt = P.nt;
    unsigned voffA[2], voffB[2];
#pragma unroll
    for (int i = 0; i < 2; ++i) { int R, C; stage_rc(tid * 16 + i * 8192, R, C); const int Rb = PERM ? ((R & ~31) + perm32(R & 31)) : R;
        voffA[i] = (unsigned)(R * P.lda + C) * 2u; voffB[i] = (unsigned)(Rb * P.ldb + C) * 2u; }
    const size_t kstepA = (size_t)P.kstepA, kstepB = (size_t)P.kstepB;
    const size_t hstepA = (size_t)HALF * P.lda * 2, hstepB = (size_t)HALF * P.ldb * 2;
    const unsigned ldsw = (unsigned)wid * 1024u;
    const int aoff = lds_byte(wr * 64 + fr, fq * 8), boff = lds_byte(wc * 32 + fr, fq * 8);
#define PG8_SA(b, h) (((b) * 2 + (h)) * HTB)
#define PG8_SB(b, h) ((4 + (b) * 2 + (h)) * HTB)
#define PG8_STAGE(bufoff, gbase, voff) do { _Pragma("unroll") for (int _i = 0; _i < 2; ++_i) \
        __builtin_amdgcn_global_load_lds((const unsigned*)((const char*)(gbase) + (voff)[_i]), (LAS unsigned*)(lds + (bufoff) + ldsw + _i * 8192), 16, 0, 0); } while (0)
#define PG8_LDA(dst, b, h) do { _Pragma("unroll") for (int m = 0; m < 4; ++m) _Pragma("unroll") for (int k = 0; k < 2; ++k) dst[m][k] = *(const LAS bf16x8*)(lds + PG8_SA(b, h) + aoff + m * 2048 + k * 1024); } while (0)
#define PG8_LDB(dst, b, h) do { _Pragma("unroll") for (int n = 0; n < 2; ++n) _Pragma("unroll") for (int k = 0; k < 2; ++k) dst[n][k] = *(const LAS bf16x8*)(lds + PG8_SB(b, h) + boff + n * 2048 + k * 1024); } while (0)
#define PG8_MMA(ai, bj, At, Bt) do { __builtin_amdgcn_s_setprio(1); _Pragma("unroll") for (int m = 0; m < 4; ++m) _Pragma("unroll") for (int n = 0; n < 2; ++n) _Pragma("unroll") for (int k = 0; k < 2; ++k) \
        acc[ai][bj][m][n] = __builtin_amdgcn_mfma_f32_16x16x32_bf16(Bt[n][k], At[m][k], acc[ai][bj][m][n], 0, 0, 0); __builtin_amdgcn_s_setprio(0); } while (0)
#define PG8_WAIT_V(n) asm volatile("s_waitcnt vmcnt(" #n ")" ::: "memory")
#define PG8_WAIT_L(n) asm volatile("s_waitcnt lgkmcnt(" #n ")" ::: "memory")
#define PG8_BAR __builtin_amdgcn_s_barrier()
#define PG8_SCHED __builtin_amdgcn_sched_barrier(0)
    Unit cur, nxt; int ui = 0;
    if (!S.next(0, cur)) return;
    f32x4 acc[2][2][4][2];
#pragma unroll
    for (int a = 0; a < 2; ++a)
#pragma unroll
        for (int b = 0; b < 2; ++b)
#pragma unroll
            for (int m = 0; m < 4; ++m)
#pragma unroll
                for (int n = 0; n < 2; ++n) acc[a][b][m][n] = (f32x4){0.f, 0.f, 0.f, 0.f};
    bf16x8 At[4][2], B0[2][2], B1[2][2];
    const char* cA = P.abase(cur); const char* cB = P.bbase(cur);
    PG8_STAGE(PG8_SB(0, 0), cB, voffB); PG8_STAGE(PG8_SA(0, 0), cA, voffA); PG8_STAGE(PG8_SB(0, 1), cB + hstepB, voffB); PG8_STAGE(PG8_SA(0, 1), cA + hstepA, voffA);
    if (wr == 1) PG8_BAR;
    PG8_WAIT_V(4); PG8_BAR;
    PG8_STAGE(PG8_SB(1, 0), cB + kstepB, voffB); PG8_STAGE(PG8_SA(1, 0), cA + kstepA, voffA); PG8_STAGE(PG8_SB(1, 1), cB + hstepB + kstepB, voffB);
    PG8_WAIT_V(6); PG8_BAR;
    for (;;) {
        const bool has_next = S.next(ui + 1, nxt);
        const char* nA = has_next ? P.abase(nxt) : cA; const char* nB = has_next ? P.bbase(nxt) : cB;
        for (int t = 0; t < nt; t += 2) {
            const bool last = (t == nt - 2);
            const char* a1 = cA + (size_t)(t + 1) * kstepA;
            const char* a2 = last ? nA : cA + (size_t)(t + 2) * kstepA; const char* b2 = last ? nB : cB + (size_t)(t + 2) * kstepB;
            const char* a3 = a2 + kstepA; const char* b3 = b2 + kstepB;
            PG8_LDB(B0, 0, 0); PG8_SCHED; PG8_LDA(At, 0, 0); PG8_STAGE(PG8_SA(1, 1), a1 + hstepA, voffA);
            PG8_WAIT_L(8); PG8_BAR; PG8_WAIT_L(0); PG8_MMA(0, 0, At, B0); PG8_BAR; PG8_SCHED;
            PG8_LDB(B1, 0, 1); PG8_STAGE(PG8_SB(0, 0), b2, voffB);
            PG8_BAR; PG8_WAIT_L(0); PG8_MMA(0, 1, At, B1); PG8_BAR;
            PG8_LDA(At, 0, 1); PG8_STAGE(PG8_SA(0, 0), a2, voffA);
            PG8_BAR; PG8_WAIT_L(0); PG8_MMA(1, 0, At, B0); PG8_BAR; PG8_SCHED;
            PG8_STAGE(PG8_SB(0, 1), b2 + hstepB, voffB);
            PG8_WAIT_V(6); PG8_BAR; PG8_MMA(1, 1, At, B1); PG8_BAR;
            PG8_LDB(B0, 1, 0); PG8_SCHED; PG8_LDA(At, 1, 0); PG8_STAGE(PG8_SA(0, 1), a2 + hstepA, voffA);
            PG8_WAIT_L(8); PG8_BAR; PG8_WAIT_L(0); PG8_MMA(0, 0, At, B0); PG8_BAR; PG8_SCHED;
            PG8_LDB(B1, 1, 1); PG8_STAGE(PG8_SB(1, 0), b3, voffB);
            PG8_BAR; PG8_WAIT_L(0); PG8_MMA(0, 1, At, B1); PG8_BAR;
            PG8_LDA(At, 1, 1); PG8_STAGE(PG8_SA(1, 0), a3, voffA);
            PG8_BAR; PG8_WAIT_L(0); PG8_MMA(1, 0, At, B0); PG8_BAR; PG8_SCHED;
            PG8_STAGE(PG8_SB(1, 1), b3 + hstepB, voffB);
            PG8_WAIT_V(6); PG8_BAR; PG8_MMA(1, 1, At, B1); PG8_BAR;
        }
        E(acc, cur, wr, wc, fr, fq);
        if (!has_next) break;
#pragma unroll
        for (int a = 0; a < 2; ++a)
#pragma unroll
            for (int b = 0; b < 2; ++b)
#pragma unroll
                for (int m = 0; m < 4; ++m)
#pragma unroll
                    for (int n = 0; n < 2; ++n) acc[a][b][m][n] = (f32x4){0.f, 0.f, 0.f, 0.f};
        cur = nxt; cA = nA; cB = nB; ++ui;
    }
    PG8_WAIT_V(0);
    if (wr == 0) PG8_BAR;
    PG8_BAR;
#undef PG8_SA
#undef PG8_SB
#undef PG8_STAGE
#undef PG8_LDA
#undef PG8_LDB
#undef PG8_MMA
#undef PG8_WAIT_V
#undef PG8_WAIT_L
#undef PG8_BAR
#undef PG8_SCHED
}
}
using pg8::Unit;

struct ProbIn {
    const char* A; const char* B; int lda, ldb, nt, kstepA, kstepB;
    __device__ __forceinline__ const char* abase(const Unit& u) const { return A + (size_t)u.pm * 256 * 4096 * 2; }
    __device__ __forceinline__ const char* bbase(const Unit& u) const { return B + (size_t)u.pn * 256 * 4096 * 2; }
};
struct ProbGate {
    const char* A; const char* B; int lda, ldb, nt, kstepA, kstepB;
    __device__ __forceinline__ const char* abase(const Unit& u) const { return A + ((size_t)u.pm * 256 * 4096 + (size_t)(u.pn >> 1) * 256) * 2; }
    __device__ __forceinline__ const char* bbase(const Unit& u) const { return B + (size_t)u.pn * 256 * 256 * 2; }
};
struct ProbOut {
    const char* A; const char* B; int lda, ldb, nt, kstepA, kstepB;
    __device__ __forceinline__ const char* abase(const Unit& u) const { return A + (size_t)u.pm * 256 * 8192 * 2; }
    __device__ __forceinline__ const char* bbase(const Unit& u) const { return B + (size_t)u.pn * 256 * 8192 * 2; }
};

struct EpiProj {
    bf16_t* O; float* LNS;
    template <int ACT, bool STATS> __device__ __forceinline__ void body(const f32x4 (&acc)[2][2][4][2], const Unit& u, int wr, int wc, int fr, int fq) const {
        const int row0 = u.pm * 256 + wr * 64 + fr;
        const int seg = u.pn >> 4, pl = u.pn & 15, cin = wc * 32 + 8 * fq;
        bf16_t* B; size_t SN; int SR, SB;
        if (seg == 0) { B = O + OFF_XA + pl * 256 + cin; SN = (size_t)128 * 4096; SR = 4096; SB = 128; }
        else if (seg == 1) { B = O + OFF_GA + (size_t)(pl * 2) * 128 * 128 + cin; SN = (size_t)32 * 128 * 128; SR = 128; SB = 128 * 128; }
        else { B = O + OFF_U + (size_t)(seg - 2) * SEGE + (size_t)pl * 128 * 256 + cin; SN = (size_t)16 * 128 * 256; SR = 256; SB = 128; }
#pragma unroll
        for (int ai = 0; ai < 2; ++ai)
#pragma unroll
            for (int m = 0; m < 4; ++m) { const int row = row0 + ai * 128 + m * 16; bf16_t* rowp = B + (size_t)(2 * u.pm + ai) * SN + (size_t)(wr * 64 + m * 16 + fr) * SR; float s1 = 0.f, s2 = 0.f;
#pragma unroll
                for (int bj = 0; bj < 2; ++bj) { f32x4 v0 = acc[ai][bj][m][0], v1 = acc[ai][bj][m][1];
                    if (ACT == 1) {
#pragma unroll
                        for (int j = 0; j < 4; ++j) { v0[j] = silu_f(v0[j]); v1[j] = silu_f(v1[j]); } }
                    if (ACT == 2) { f32x2 a = gelu_pk((f32x2){v0[0], v0[1]}), b = gelu_pk((f32x2){v0[2], v0[3]}), c = gelu_pk((f32x2){v1[0], v1[1]}), d = gelu_pk((f32x2){v1[2], v1[3]});
                        v0 = (f32x4){a.x, a.y, b.x, b.y}; v1 = (f32x4){c.x, c.y, d.x, d.y}; }
                    if (STATS) { s1 += ((v0[0] + v0[1]) + (v0[2] + v0[3])) + ((v1[0] + v1[1]) + (v1[2] + v1[3]));
                        s2 += ((v0[0] * v0[0] + v0[1] * v0[1]) + (v0[2] * v0[2] + v0[3] * v0[3])) + ((v1[0] * v1[0] + v1[1] * v1[1]) + (v1[2] * v1[2] + v1[3] * v1[3])); }
                    u32x4 w; w.x = pk2(v0[0], v0[1]); w.y = pk2(v0[2], v0[3]); w.z = pk2(v1[0], v1[1]); w.w = pk2(v1[2], v1[3]);
                    *(u32x4*)(rowp + bj * SB) = w; }
                if (STATS) { s1 += __shfl_xor(s1, 16); s1 += __shfl_xor(s1, 32); s2 += __shfl_xor(s2, 16); s2 += __shfl_xor(s2, 32);
                    if (fq == 0) *(f32x2*)(LNS + ((size_t)row * 64 + (u.pn & 15) * 4 + wc) * 2) = (f32x2){s1, s2}; } }
    }
    __device__ __forceinline__ void operator()(const f32x4 (&acc)[2][2][4][2], const Unit& u, int wr, int wc, int fr, int fq) const {
        const int seg = u.pn >> 4;
        if (seg == 3) body<2, true>(acc, u, wr, wc, fr, fq);
        else body<0, false>(acc, u, wr, wc, fr, fq);
    }
};
struct EpiGate {
    const bf16_t* XC; const float* ba; const float* bx; const float* sp8; bf16_t* LOGA; bf16_t* INP;
    __device__ __forceinline__ void operator()(const f32x4 (&acc)[2][2][4][2], const Unit& u, int wr, int wc, int fr, int fq) const {
        const int cb = (u.pn >> 1) * 256 + (u.pn & 1) * 128 + wc * 32 + 8 * fq;
        float bav[8], bxv[8], spv[8];
        { const f32x4 t0 = *(const f32x4*)(ba + cb), t1 = *(const f32x4*)(ba + cb + 4), t2 = *(const f32x4*)(bx + cb), t3 = *(const f32x4*)(bx + cb + 4), t4 = *(const f32x4*)(sp8 + cb), t5 = *(const f32x4*)(sp8 + cb + 4);
#pragma unroll
          for (int j = 0; j < 4; ++j) { bav[j] = t0[j]; bav[4 + j] = t1[j]; bxv[j] = t2[j]; bxv[4 + j] = t3[j]; spv[j] = t4[j]; spv[4 + j] = t5[j]; } }
        u32x4 xwv[2][4];
#pragma unroll
        for (int ai = 0; ai < 2; ++ai)
#pragma unroll
            for (int m = 0; m < 4; ++m) xwv[ai][m] = __builtin_nontemporal_load((const u32x4*)(XC + (size_t)(u.pm * 256 + ai * 128 + wr * 64 + m * 16 + fr) * WA + cb));
#pragma unroll
        for (int ai = 0; ai < 2; ++ai)
#pragma unroll
            for (int m = 0; m < 4; ++m) {
                const size_t off = (size_t)(u.pm * 256 + ai * 128 + wr * 64 + m * 16 + fr) * WA + cb;
                const u32x4 xw = xwv[ai][m];
                float xc[8] = {bflo(xw.x), bfhi(xw.x), bflo(xw.y), bfhi(xw.y), bflo(xw.z), bfhi(xw.z), bflo(xw.w), bfhi(xw.w)};
                float la[8], ip[8];
#pragma unroll
                for (int e = 0; e < 8; ++e) { const int n = e >> 2, j = e & 3;
                    const float r = fast_sigmoid(acc[ai][0][m][n][j] + bav[e]), ig = fast_sigmoid(acc[ai][1][m][n][j] + bxv[e]);
                    const float l = -r * spv[e];
                    const float a2 = __builtin_amdgcn_exp2f(2.0f * 1.4426950408889634f * l);
                    la[e] = l; ip[e] = __builtin_sqrtf(fmaxf(1.0f - a2, 0.f)) * ig * xc[e]; }
                u32x4 w0, w1; w0.x = pk2(la[0], la[1]); w0.y = pk2(la[2], la[3]); w0.z = pk2(la[4], la[5]); w0.w = pk2(la[6], la[7]);
                w1.x = pk2(ip[0], ip[1]); w1.y = pk2(ip[2], ip[3]); w1.z = pk2(ip[4], ip[5]); w1.w = pk2(ip[6], ip[7]);
                const size_t toff = ((size_t)((2 * u.pm + ai) * 32 + u.pn) * 128 + (wr * 64 + m * 16 + fr)) * 128 + wc * 32 + 8 * fq;
                *(u32x4*)(LOGA + toff) = w0; *(u32x4*)(INP + toff) = w1;
            }
    }
};
struct EpiOut {
    const float* X; float* O; float* SS;
    __device__ __forceinline__ void operator()(const f32x4 (&acc)[2][2][4][2], const Unit& u, int wr, int wc, int fr, int fq) const {
        const int row0 = u.pm * 256 + wr * 64 + fr, col0 = u.pn * 256 + wc * 32 + 4 * fq;
#pragma unroll
        for (int ai = 0; ai < 2; ++ai)
#pragma unroll
            for (int m = 0; m < 4; ++m) { const int row = row0 + ai * 128 + m * 16; const size_t off = (size_t)row * DM + col0; float ss = 0.f;
#pragma unroll
                for (int bj = 0; bj < 2; ++bj)
#pragma unroll
                    for (int n = 0; n < 2; ++n) { const f32x4 xv = *(const f32x4*)(X + off + bj * 128 + n * 16); const f32x4 o = xv + acc[ai][bj][m][n];
                        ss += (o[0] * o[0] + o[1] * o[1]) + (o[2] * o[2] + o[3] * o[3]); *(f32x4*)(O + off + bj * 128 + n * 16) = o; }
                ss += __shfl_xor(ss, 16); ss += __shfl_xor(ss, 32);
                if (fq == 0) SS[(size_t)row * 64 + u.pn * 4 + wc] = ss; }
    }
};

struct OrderPanel {
    int c;
    __device__ bool next(int i, Unit& u) const { if (i >= 2) return false; const int x = c & 7, j = c >> 3; u.pm = 16 * i + 4 * (x >> 1) + (j >> 3); u.pn = 8 * (x & 1) + (j & 7); return true; }
};
struct EpiOutFused {
    const float* X; float* O; float* SS; unsigned* CNT; const float* FG;
    __device__ __forceinline__ void operator()(f32x4 (&acc)[2][2][4][2], const Unit& u, int wr, int wc, int fr, int fq) const {
        const int row0 = u.pm * 256 + wr * 64 + fr, col0 = u.pn * 256 + wc * 32 + 4 * fq;
#pragma unroll
        for (int ai = 0; ai < 2; ++ai)
#pragma unroll
            for (int m = 0; m < 4; ++m) { const int row = row0 + ai * 128 + m * 16; const size_t off = (size_t)row * DM + col0; float ss = 0.f;
#pragma unroll
                for (int bj = 0; bj < 2; ++bj)
#pragma unroll
                    for (int n = 0; n < 2; ++n) { const f32x4 xv = __builtin_nontemporal_load((const f32x4*)(X + off + bj * 128 + n * 16)); const f32x4 o = xv + acc[ai][bj][m][n]; acc[ai][bj][m][n] = o;
                        ss += (o[0] * o[0] + o[1] * o[1]) + (o[2] * o[2] + o[3] * o[3]); }
                ss += __shfl_xor(ss, 16); ss += __shfl_xor(ss, 32);
                if (fq == 0) __hip_atomic_store((unsigned*)(SS + (size_t)row * 64 + u.pn * 4 + wc), __float_as_uint(ss), __ATOMIC_RELAXED, __HIP_MEMORY_SCOPE_AGENT); }
        asm volatile("s_waitcnt vmcnt(0)" ::: "memory");
        unsigned* cnt = CNT + 64 * u.pm;
        if ((threadIdx.x & 63) == 0) __hip_atomic_fetch_add(cnt, 1u, __ATOMIC_RELAXED, __HIP_MEMORY_SCOPE_AGENT);
        asm volatile("" ::: "memory"); __builtin_amdgcn_s_barrier(); asm volatile("" ::: "memory");
        { unsigned sp = 0;
          while ((unsigned)__builtin_amdgcn_readfirstlane(__hip_atomic_load(cnt, __ATOMIC_RELAXED, __HIP_MEMORY_SCOPE_AGENT)) < 128u) { __builtin_amdgcn_s_sleep(2); if (++sp > (1u << 20)) break; } }
        __builtin_amdgcn_fence(__ATOMIC_ACQUIRE, "agent");
        asm volatile("s_waitcnt vmcnt(0)" ::: "memory");
        f32x4 gv[2][2];
#pragma unroll
        for (int bj = 0; bj < 2; ++bj)
#pragma unroll
            for (int n = 0; n < 2; ++n) gv[bj][n] = *(const f32x4*)(FG + col0 + bj * 128 + n * 16);
#pragma unroll
        for (int ai = 0; ai < 2; ++ai)
#pragma unroll
            for (int m = 0; m < 4; ++m) { const int row = row0 + ai * 128 + m * 16; const f32x4* sp4 = (const f32x4*)(SS + (size_t)row * 64);
                const f32x4 a = sp4[fq], b = sp4[fq + 4], c = sp4[fq + 8], d = sp4[fq + 12];
                float t = ((a[0] + a[1]) + (a[2] + a[3])) + ((b[0] + b[1]) + (b[2] + b[3])) + ((c[0] + c[1]) + (c[2] + c[3])) + ((d[0] + d[1]) + (d[2] + d[3]));
                t += __shfl_xor(t, 16); t += __shfl_xor(t, 32);
                const float rstd = 1.0f / sqrtf(t * (1.0f / DM) + EPS); const size_t off = (size_t)row * DM + col0;
#pragma unroll
                for (int bj = 0; bj < 2; ++bj)
#pragma unroll
                    for (int n = 0; n < 2; ++n) __builtin_nontemporal_store(acc[ai][bj][m][n] * rstd * gv[bj][n], (f32x4*)(O + off + bj * 128 + n * 16)); }
    }
};

template <bool NTS> __device__ __forceinline__ void p0_transpose_item(const float* __restrict__ src, int ldw, bf16_t* __restrict__ dst, int ldd, LAS float* scr, int lane) {
    f32x4 v[16];
#pragma unroll
    for (int i = 0; i < 16; ++i) v[i] = __builtin_nontemporal_load((const f32x4*)(src + (size_t)(4 * i + (lane >> 4)) * ldw + (lane & 15) * 4));
#pragma unroll
    for (int i = 0; i < 16; ++i) { LAS float* p = scr + (4 * i + (lane >> 4)) * 65 + (lane & 15) * 4; p[0] = v[i].x; p[1] = v[i].y; p[2] = v[i].z; p[3] = v[i].w; }
    LDS_WAIT();
    const int c = lane & 7;
#pragma unroll
    for (int j = 0; j < 8; ++j) { const int n = (lane >> 3) + 8 * j; const LAS float* s = scr + (8 * c) * 65 + n;
        u32x4 o; o.x = pk2(s[0 * 65], s[1 * 65]); o.y = pk2(s[2 * 65], s[3 * 65]); o.z = pk2(s[4 * 65], s[5 * 65]); o.w = pk2(s[6 * 65], s[7 * 65]);
        if (NTS) __builtin_nontemporal_store(o, (u32x4*)(dst + (size_t)n * ldd + 8 * c)); else *(u32x4*)(dst + (size_t)n * ldd + 8 * c) = o; }
    LDS_WAIT();
}

__device__ __forceinline__ void phase0(const Params& p, LAS unsigned char* lds, int gw, int NGW, int wave, int lane, int nbk  ) {
    unsigned char* ws = p.ws;
    bf16_t* WINT = (bf16_t*)(ws + WS_WINT); bf16_t* WOUTT = (bf16_t*)(ws + WS_WOUTT); bf16_t* WGT = (bf16_t*)(ws + WS_WGT); bf16_t* WSP = (bf16_t*)(ws + WS_WSP);
    float* SP8 = (float*)(ws + WS_SP8); bf16_t* HN = (bf16_t*)(ws + WS_HN);
    LAS float* scr = (LAS float*)(lds + wave * (64 * 65 * 4));
    const int I_IN = 64 * nbk; constexpr int I_G = 2 * 16 * 16;
    for (int it = gw; it < I_IN + I_G; it += NGW) {
        int r = it;
        if (r < I_IN) { const int kb = r / nbk, nb = r % nbk; p0_transpose_item<false>(p.w_in + (size_t)(64 * kb) * INC + 64 * nb, INC, WINT + ((size_t)((nb >> 2) * 64 + kb) * 256 + (nb & 3) * 64) * 64, 64, scr, lane); continue; }
        r -= I_IN;
        { const int mat = r >> 8, h = (r >> 4) & 15, kb = (r >> 2) & 3, nb = r & 3; const int n0 = 64 * nb, k0 = 64 * kb;
          const float* src = (mat ? p.w_gate_x : p.w_gate_a) + (size_t)h * 65536 + (size_t)k0 * 256 + n0;
          bf16_t* dst = WGT + (size_t)((h * 2 + (n0 >> 7)) * 256 + mat * 128 + (n0 & 127)) * 256 + k0;
          p0_transpose_item<false>(src, 256, dst, 256, scr, lane); }
    }
    const int gt = gw * 64 + lane, NGT = NGW * 64;
    for (int i = gt; i < 16 * 128 * 128; i += NGT) { const int ii = (i >> 7) & 127, jj = i & 127; const float v = ((jj >> 6) <= (ii >> 6)) ? p.w_spatial[i] : 0.f; WSP[i] = (bf16_t)(pk2(v, 0.f) & 0xffffu); }
    for (int i = gt; i < 4096; i += NGT) { const float l = -p.lru_lambda[i]; const float sp = (l > 20.f) ? l : log1pf(__expf(l)); SP8[i] = 8.0f * sp; }
    for (int row = gw; row < SEQ; row += NGW) {
        const f32x4* xr = (const f32x4*)(p.x + (size_t)row * DM) + lane; const f32x4* gr = (const f32x4*)p.norm_g + lane;
        f32x4 v[16]; float s = 0.f;
#pragma unroll
        for (int j = 0; j < 16; ++j) { v[j] = __builtin_nontemporal_load(xr + 64 * j); s += (v[j].x * v[j].x + v[j].y * v[j].y) + (v[j].z * v[j].z + v[j].w * v[j].w); }
        const float rstd = 1.0f / sqrtf(wave_sum(s) * (1.0f / DM) + EPS);
        u32x2* o = (u32x2*)(HN + (size_t)row * DM) + lane;
#pragma unroll
        for (int j = 0; j < 16; ++j) { const f32x4 g = gr[64 * j]; u32x2 w; w.x = pk2(v[j].x * rstd * g.x, v[j].y * rstd * g.y); w.y = pk2(v[j].z * rstd * g.z, v[j].w * rstd * g.w); o[64 * j] = w; }
    }
}

__device__ __forceinline__ void stats_rows(const Params& p, int gw, int NGW, int lane) {
    unsigned char* ws = p.ws;
    { const float* LNS = (const float*)(ws + WS_LNS); float* STAT = (float*)(ws + WS_STAT);
      for (int row = gw; row < SEQ; row += NGW) { const f32x2 pr = *(const f32x2*)(LNS + ((size_t)row * 64 + lane) * 2);
          const float s1 = wave_sum(pr.x), s2 = wave_sum(pr.y); const float mean = s1 * (1.0f / WB); const float var = fmaxf(s2 * (1.0f / WB) - mean * mean, 0.f);
          if (lane == 0) *(f32x2*)(STAT + (size_t)row * 2) = (f32x2){mean, 1.0f / sqrtf(var + EPS)}; } }
}

template <bool NTS> __device__ __forceinline__ void transpose_slice(const float* W, int ldw, bf16_t* WT, int ntk  , int nbw, int nb0, LAS unsigned char* lds, int it0, int it1, int w, int nw, int wave, int lane) {
    LAS float* scr = (LAS float*)(lds + wave * (64 * 65 * 4));
    f32x4 v[16];
    int r = it0 + w;
    if (r < it1) { const float* src = W + (size_t)(64 * (r / nbw)) * ldw + 64 * (nb0 + r % nbw);
#pragma unroll
        for (int i = 0; i < 16; ++i) v[i] = __builtin_nontemporal_load((const f32x4*)(src + (size_t)(4 * i + (lane >> 4)) * ldw + (lane & 15) * 4)); }
    while (r < it1) {
        const int kb = r / nbw, nb = nb0 + r % nbw; bf16_t* dst = WT + ((size_t)((nb >> 2) * ntk + kb) * 256 + (nb & 3) * 64) * 64; constexpr int ldd = 64;
#pragma unroll
        for (int i = 0; i < 16; ++i) { LAS float* q = scr + (4 * i + (lane >> 4)) * 65 + (lane & 15) * 4; q[0] = v[i].x; q[1] = v[i].y; q[2] = v[i].z; q[3] = v[i].w; }
        r += nw;
        if (r < it1) { const float* src = W + (size_t)(64 * (r / nbw)) * ldw + 64 * (nb0 + r % nbw);
#pragma unroll
            for (int i = 0; i < 16; ++i) v[i] = __builtin_nontemporal_load((const f32x4*)(src + (size_t)(4 * i + (lane >> 4)) * ldw + (lane & 15) * 4)); }
        LDS_WAIT();
        const int c = lane & 7;
#pragma unroll
        for (int j = 0; j < 8; ++j) { const int n = (lane >> 3) + 8 * j; const LAS float* sq = scr + (8 * c) * 65 + n;
            u32x4 o; o.x = pk2(sq[0 * 65], sq[1 * 65]); o.y = pk2(sq[2 * 65], sq[3 * 65]); o.z = pk2(sq[4 * 65], sq[5 * 65]); o.w = pk2(sq[6 * 65], sq[7 * 65]);
            if (NTS) __builtin_nontemporal_store(o, (u32x4*)(dst + (size_t)n * ldd + 8 * c)); else *(u32x4*)(dst + (size_t)n * ldd + 8 * c) = o; }
        LDS_WAIT();
    }
}

__device__ __forceinline__ void unpack8(const u32x4 w, float (&f)[8]) { f[0] = bflo(w.x); f[1] = bfhi(w.x); f[2] = bflo(w.y); f[3] = bfhi(w.y); f[4] = bflo(w.z); f[5] = bfhi(w.z); f[6] = bflo(w.w); f[7] = bfhi(w.w); }
__device__ __forceinline__ u32x4 pack8(const float (&f)[8]) { u32x4 w; w.x = pk2(f[0], f[1]); w.y = pk2(f[2], f[3]); w.z = pk2(f[4], f[5]); w.w = pk2(f[6], f[7]); return w; }

__device__ __forceinline__ void conv_items(const Params& p, int gw, int NGW, int lane) {
    unsigned char* ws = p.ws;
    const bf16_t* PROJ = (const bf16_t*)(ws + WS_PROJ); bf16_t* XC = (bf16_t*)(ws + WS_XC);
    for (int it = gw; it < 512 * 8; it += NGW) {
        const int rb = it >> 3, cs = it & 7, t0 = rb * 16, c0 = cs * 512 + lane * 8;
        float w[4][8], b[8];
#pragma unroll
        for (int k = 0; k < 4; ++k) { const f32x4 a = *(const f32x4*)(p.conv_w + k * WA + c0), bb = *(const f32x4*)(p.conv_w + k * WA + c0 + 4);
#pragma unroll
            for (int j = 0; j < 4; ++j) { w[k][j] = a[j]; w[k][4 + j] = bb[j]; } }
        { const f32x4 a = *(const f32x4*)(p.conv_b + c0), bb = *(const f32x4*)(p.conv_b + c0 + 4);
#pragma unroll
          for (int j = 0; j < 4; ++j) { b[j] = a[j]; b[4 + j] = bb[j]; } }
        u32x4 rows[19];
#pragma unroll
        for (int i = 0; i < 19; ++i) { const int t = t0 - 3 + i; rows[i] = (t >= 0) ? __builtin_nontemporal_load((const u32x4*)(PROJ + OFF_XA + (size_t)t * 4096 + c0)) : (u32x4){0u, 0u, 0u, 0u}; }
#pragma unroll
        for (int i = 0; i < 16; ++i) { float x0[8], x1[8], x2[8], x3[8], o[8];
            unpack8(rows[i], x0); unpack8(rows[i + 1], x1); unpack8(rows[i + 2], x2); unpack8(rows[i + 3], x3);
#pragma unroll
            for (int e = 0; e < 8; ++e) o[e] = b[e] + x0[e] * w[0][e] + x1[e] * w[1][e] + x2[e] * w[2][e] + x3[e] * w[3][e];
            *(u32x4*)(XC + (size_t)(t0 + i) * WA + c0) = pack8(o); }
    }
}


constexpr int VT_PITCH = 528, WS_PITCH = 272, VT_BYTES = 128 * VT_PITCH, WL_BYTES = 128 * WS_PITCH;
constexpr int SP_STAT = VT_BYTES + WL_BYTES, SP_BSP = SP_STAT + 2 * 128 * 8, SP_LNG = SP_BSP + 128 * 4, SP_LNB = SP_LNG + 256 * 4;
__device__ __forceinline__ void spatial_phase(const Params& p, LAS unsigned char* lds, int bid, int G, int tid, int wave, int lane) {
    unsigned char* ws = p.ws;
    const bf16_t* PROJ = (const bf16_t*)(ws + WS_PROJ); const float* STAT = (const float*)(ws + WS_STAT); const bf16_t* WSP = (const bf16_t*)(ws + WS_WSP); bf16_t* MIXED = (bf16_t*)(ws + WS_MIXED);
    LAS unsigned char* vt = lds; LAS unsigned char* wl = lds + VT_BYTES;
    LAS f32x2* statbuf = (LAS f32x2*)(lds + SP_STAT); LAS float* bsp = (LAS float*)(lds + SP_BSP); LAS float* lng = (LAS float*)(lds + SP_LNG); LAS float* lnb = (LAS float*)(lds + SP_LNB);
    const int r = lane & 15, q = lane >> 4;
    const int srow = tid >> 5, sch = tid & 31;
    constexpr int NIT = 64 * 16;
    u32x4 vraw[8]; f32x2 stn = (f32x2){0.f, 0.f};
    int cur_g = -1, par = 0;
    int it = bid;
    __syncthreads();
    if (it < NIT) { const int t0 = (it >> 4) * 128;
#pragma unroll
        for (int e = 0; e < 8; ++e) vraw[e] = __builtin_nontemporal_load((const u32x4*)(PROJ + OFF_V + ((size_t)it * 128 + srow + 16 * e) * 256 + sch * 8));
        if (tid < 128) statbuf[tid] = *(const f32x2*)(STAT + (size_t)(t0 + tid) * 2); }
    for (; it < NIT; it += G, par ^= 1) {
        const int n = it >> 4, g = it & 15, t0 = n * 128, cb = g * 256;
        const bool has_next = (it + G < NIT);
        __syncthreads();
        if (g != cur_g) { cur_g = g;
#pragma unroll
            for (int e = 0; e < 4; ++e) { const int pc = tid + 512 * e, row = pc >> 4, ch = pc & 15;
                *(LAS u32x4*)(wl + row * WS_PITCH + ch * 16) = *(const u32x4*)(WSP + (size_t)g * 16384 + row * 128 + ch * 8); }
            if (tid < 128) bsp[tid] = p.b_spatial[g * 128 + tid];
            if (tid < 256) { lng[tid] = p.ln_v_g[cb + tid]; lnb[tid] = p.ln_v_b[cb + tid]; }
            __syncthreads(); }
        { const f32x4 g0 = *(const LAS f32x4*)(lng + sch * 8), g1 = *(const LAS f32x4*)(lng + sch * 8 + 4), b0 = *(const LAS f32x4*)(lnb + sch * 8), b1 = *(const LAS f32x4*)(lnb + sch * 8 + 4);
#pragma unroll
          for (int e = 0; e < 8; ++e) { float x[8]; unpack8(vraw[e], x); const f32x2 st = statbuf[par * 128 + srow + 16 * e];
#pragma unroll
            for (int j = 0; j < 4; ++j) { x[j] = (x[j] - st.x) * st.y * g0[j] + b0[j]; x[4 + j] = (x[4 + j] - st.x) * st.y * g1[j] + b1[j]; }
            *(LAS u32x4*)(vt + (srow + 16 * e) * VT_PITCH + sch * 16) = pack8(x); } }
        u32x4 uu[4], gg[4];
#pragma unroll
        for (int i = 0; i < 4; ++i) { const size_t o = ((size_t)it * 128 + 16 * i + r) * 256 + 32 * wave + 8 * q; uu[i] = __builtin_nontemporal_load((const u32x4*)(PROJ + OFF_U + o)); gg[i] = __builtin_nontemporal_load((const u32x4*)(PROJ + OFF_GB + o)); }
        if (has_next) { const int nt0 = ((it + G) >> 4) * 128;
#pragma unroll
            for (int e = 0; e < 8; ++e) vraw[e] = __builtin_nontemporal_load((const u32x4*)(PROJ + OFF_V + ((size_t)(it + G) * 128 + srow + 16 * e) * 256 + sch * 8));
            if (tid < 128) stn = *(const f32x2*)(STAT + (size_t)(nt0 + tid) * 2); }
        __syncthreads();
        f32x4 acc[2][8];
#pragma unroll
        for (int dt = 0; dt < 2; ++dt)
#pragma unroll
            for (int i = 0; i < 8; ++i) acc[dt][i] = (f32x4){0.f, 0.f, 0.f, 0.f};
#pragma unroll
        for (int ks = 0; ks < 4; ++ks) {
            bf16x8 af[2];
#pragma unroll
            for (int dt = 0; dt < 2; ++dt) { const int chl = 32 * wave + 8 * (r >> 2) + 4 * dt + (r & 3);
#pragma unroll
                for (int e = 0; e < 8; ++e) af[dt][e] = (short)*(const LAS unsigned short*)(vt + (ks * 32 + 8 * q + e) * VT_PITCH + chl * 2); }
#pragma unroll
            for (int i = 0; i < 8; ++i) { if (i < 4 && ks >= 2) continue;
                const bf16x8 bfr = *(const LAS bf16x8*)(wl + (16 * i + r) * WS_PITCH + (ks * 32 + 8 * q) * 2);
#pragma unroll
                for (int dt = 0; dt < 2; ++dt) acc[dt][i] = __builtin_amdgcn_mfma_f32_16x16x32_bf16(af[dt], bfr, acc[dt][i], 0, 0, 0); }
        }
        u32x4 uu2[4], gg2[4];
#pragma unroll
        for (int i = 0; i < 4; ++i) { const size_t o = ((size_t)it * 128 + 16 * (i + 4) + r) * 256 + 32 * wave + 8 * q; uu2[i] = __builtin_nontemporal_load((const u32x4*)(PROJ + OFF_U + o)); gg2[i] = __builtin_nontemporal_load((const u32x4*)(PROJ + OFF_GB + o)); }
#pragma unroll
        for (int i = 0; i < 8; ++i) { const int t = t0 + 16 * i + r; const int ch = cb + 32 * wave + 8 * q;
            const float bs = bsp[16 * i + r];
            float u8[8], g8[8], o[8];
            unpack8(i < 4 ? uu[i & 3] : uu2[i & 3], u8); unpack8(i < 4 ? gg[i & 3] : gg2[i & 3], g8);
#pragma unroll
            for (int e = 0; e < 8; e += 2) { const f32x2 gl = gelu_pk((f32x2){u8[e], u8[e + 1]}); u8[e] = gl.x; u8[e + 1] = gl.y; }
#pragma unroll
            for (int e = 0; e < 8; ++e) o[e] = u8[e] * (acc[e >> 2][i][e & 3] + bs) * silu_f(g8[e]);
            *(u32x4*)(MIXED + ((size_t)((t >> 8) * 128 + ((4096 + ch) >> 6)) * 256 + (t & 255)) * 64 + (ch & 63)) = pack8(o);
            __builtin_amdgcn_sched_barrier(0); }
        if (has_next && tid < 128) statbuf[(par ^ 1) * 128 + tid] = stn;
    }
}

__device__ __forceinline__ void scan1_item(const Params& p, int it, int lane) {
    unsigned char* ws = p.ws;
    const unsigned* LOGA = (const unsigned*)(ws + WS_LOGA); const unsigned* INP = (const unsigned*)(ws + WS_INP);
    float* PP = (float*)(ws + WS_P); float* HE = (float*)(ws + WS_HEND);
    {
        const int k = it >> 5, s = it & 31; const size_t base = (size_t)it * (128 * 64) + lane;
        float h0 = 0.f, h1 = 0.f, l0 = 0.f, l1 = 0.f;
#pragma unroll 1
        for (int tb = 0; tb < 128; tb += 16) {
            unsigned la[16], ip[16];
#pragma unroll
            for (int i = 0; i < 16; ++i) { la[i] = LOGA[base + (size_t)(tb + i) * 64]; ip[i] = INP[base + (size_t)(tb + i) * 64]; }
#pragma unroll
            for (int i = 0; i < 16; ++i) { const float a0 = bflo(la[i]), a1 = bfhi(la[i]); l0 += a0; l1 += a1;
                h0 = __builtin_amdgcn_exp2f(1.4426950408889634f * a0) * h0 + bflo(ip[i]); h1 = __builtin_amdgcn_exp2f(1.4426950408889634f * a1) * h1 + bfhi(ip[i]); }
        }
        const int c = s * 128 + lane * 2;
        *(f32x2*)(PP + (size_t)k * WA + c) = (f32x2){__builtin_amdgcn_exp2f(1.4426950408889634f * l0), __builtin_amdgcn_exp2f(1.4426950408889634f * l1)};
        *(f32x2*)(HE + (size_t)k * WA + c) = (f32x2){h0, h1};
    }
}
__device__ __forceinline__ void scan1_phase(const Params& p, int gw, int NGW, int lane) { for (int it = gw; it < 64 * 32; it += NGW) scan1_item(p, it, lane); }
__device__ __forceinline__ void scan2_phase(const Params& p, int gw, int NGW, int lane) {
    unsigned char* ws = p.ws;
    const unsigned* LOGA = (const unsigned*)(ws + WS_LOGA); const unsigned* INP = (const unsigned*)(ws + WS_INP); const unsigned* PROJ = (const unsigned*)(ws + WS_PROJ);
    const float* PP = (const float*)(ws + WS_P); const float* HE = (const float*)(ws + WS_HEND); unsigned* MIXED = (unsigned*)(ws + WS_MIXED);
    for (int it = gw; it < 64 * 32; it += NGW) {
        const int k = it >> 5, s = it & 31; const int c = s * 128 + lane * 2;
        float h0 = 0.f, h1 = 0.f;
        for (int kb = 0; kb < k; kb += 16) { f32x2 pp[16], he[16];
#pragma unroll
            for (int j = 0; j < 16; ++j) { const int kk = (kb + j) & 63; pp[j] = *(const f32x2*)(PP + (size_t)kk * WA + c); he[j] = *(const f32x2*)(HE + (size_t)kk * WA + c); }
#pragma unroll
            for (int j = 0; j < 16; ++j) { const bool on = (kb + j) < k; const float p0 = on ? pp[j].x : 1.f, p1 = on ? pp[j].y : 1.f, e0 = on ? he[j].x : 0.f, e1 = on ? he[j].y : 0.f; h0 = p0 * h0 + e0; h1 = p1 * h1 + e1; } }
        const size_t base = (size_t)it * (128 * 64) + lane;
#pragma unroll 1
        for (int tb = 0; tb < 128; tb += 16) {
            unsigned la[16], ip[16], ga[16];
#pragma unroll
            for (int i = 0; i < 16; ++i) { la[i] = __builtin_nontemporal_load(LOGA + base + (size_t)(tb + i) * 64); ip[i] = __builtin_nontemporal_load(INP + base + (size_t)(tb + i) * 64);
                ga[i] = __builtin_nontemporal_load(PROJ + OFF_GA / 2 + base + (size_t)(tb + i) * 64); }
#pragma unroll
            for (int i = 0; i < 16; ++i) { const float a0 = bflo(la[i]), a1 = bfhi(la[i]);
                h0 = __builtin_amdgcn_exp2f(1.4426950408889634f * a0) * h0 + bflo(ip[i]); h1 = __builtin_amdgcn_exp2f(1.4426950408889634f * a1) * h1 + bfhi(ip[i]);
                { const int t = k * 128 + tb + i; MIXED[((size_t)((t >> 8) * 128 + 2 * s + (lane >> 5)) * 256 + (t & 255)) * 32 + (lane & 31)] = pk2(h0 * silu_f(bflo(ga[i])), h1 * silu_f(bfhi(ga[i]))); } }
        }
    }
}

__device__ __forceinline__ void final_phase(const Params& p, int gw, int NGW, int lane) {
    const float* SS = (const float*)(p.ws + WS_SS);
    for (int row = gw; row < SEQ; row += NGW) {
        const float ss = wave_sum(SS[(size_t)row * 64 + lane]);
        const float rstd = 1.0f / sqrtf(ss * (1.0f / DM) + EPS);
        f32x4* xr = (f32x4*)(p.out + (size_t)row * DM) + lane; const f32x4* gr = (const f32x4*)p.final_g + lane;
        f32x4 v[16];
#pragma unroll
        for (int j = 0; j < 16; ++j) v[j] = xr[64 * j];
#pragma unroll
        for (int j = 0; j < 16; ++j) { const f32x4 g = gr[64 * j]; xr[64 * j] = v[j] * rstd * g; }
    }
}

#define XB_TMO      128
#define XB_XCNT(j)  (256  + 64 * (j))
#define XB_XSUB(j)  (1280 + 64 * (j))
#define XB_XGEN(j)  (2304 + 64 * (j))
#define XB_TOP      3328
#define XB_TOPGEN   3392
#define XB_SPIN_CAP (1u << 20)
__device__ __forceinline__ unsigned xb_ld(unsigned* p)              { return __hip_atomic_load(p, __ATOMIC_RELAXED, __HIP_MEMORY_SCOPE_AGENT); }
__device__ __forceinline__ unsigned xb_add(unsigned* p, unsigned v) { return __hip_atomic_fetch_add(p, v, __ATOMIC_RELAXED, __HIP_MEMORY_SCOPE_AGENT); }
__device__ __forceinline__ unsigned xb_xcc_id() { return (unsigned)__builtin_amdgcn_s_getreg((3 << 11) | 20) & 0xFu; }
#define XB_SPIN(cond, bar) do { unsigned _sp = 0; while (cond) { __builtin_amdgcn_s_sleep(1); \
    if ((++_sp & 255u) == 0u) { if (xb_ld(&(bar)[XB_TMO])) break; if (_sp > XB_SPIN_CAP) { atomicAdd(&(bar)[XB_TMO], 1u); break; } } } } while (0)
struct XcdBarrier { unsigned* bar; unsigned x; volatile LAS unsigned* st; unsigned total; };
__device__ __forceinline__ XcdBarrier xcd_barrier_post(unsigned* bar, volatile LAS unsigned* st, unsigned total) {
    XcdBarrier b; b.bar = bar; b.x = xb_xcc_id(); b.st = st; b.total = total;
    if (threadIdx.x == 0) (void)xb_add(&bar[XB_XCNT(b.x)], 1u);
    return b;
}
__device__ __forceinline__ void xcd_barrier_complete(unsigned* bar, unsigned x, unsigned& nloc, unsigned& nx, unsigned G) {
    unsigned sum, cnt, mine, sp = 0u;
    for (;;) {
        sum = 0u; cnt = 0u; mine = 0u;
#pragma unroll
        for (unsigned j = 0; j < 16; ++j) { const unsigned c = xb_ld(&bar[XB_XCNT(j)]); sum += c; cnt += (c > 0u) ? 1u : 0u; mine = (j == x) ? c : mine; }
        if (sum == G) break;
        __builtin_amdgcn_s_sleep(1);
        if ((++sp & 255u) == 0u) { if (xb_ld(&bar[XB_TMO])) break; if (sp > XB_SPIN_CAP) { atomicAdd(&bar[XB_TMO], 1u); break; } }
    }
    nloc = mine > 0u ? mine : 1u; nx = cnt > 0u ? cnt : 1u;
}
__device__ __forceinline__ void xcd_barrier(const XcdBarrier& b) {
    asm volatile("s_waitcnt vmcnt(0)" ::: "memory");
    __syncthreads();
    if (threadIdx.x == 0) {
        unsigned* bar = b.bar;
        __builtin_amdgcn_s_waitcnt(0);
        unsigned nloc = b.st[0], nx = b.st[1];
        if (nloc == 0u) { xcd_barrier_complete(bar, b.x, nloc, nx, b.total); b.st[0] = nloc; b.st[1] = nx; }
        const unsigned old = xb_add(&bar[XB_XSUB(b.x)], 1u);
        const unsigned gen = old / nloc;
        if (old + 1u == (gen + 1u) * nloc) {
            __builtin_amdgcn_fence(__ATOMIC_RELEASE, "agent");
            asm volatile("s_waitcnt vmcnt(0)" ::: "memory");
            const unsigned og = xb_add(&bar[XB_TOP], 1u);
            const unsigned tg = og / nx;
            if (og + 1u == (tg + 1u) * nx) xb_add(&bar[XB_TOPGEN], 1u);
            else XB_SPIN(xb_ld(&bar[XB_TOPGEN]) == tg, bar);
            __builtin_amdgcn_fence(__ATOMIC_ACQUIRE, "agent");
            xb_add(&bar[XB_XGEN(b.x)], 1u);
            asm volatile("s_waitcnt vmcnt(0)" ::: "memory");
        } else {
            XB_SPIN(xb_ld(&bar[XB_XGEN(b.x)]) == gen, bar);
            __builtin_amdgcn_fence(__ATOMIC_ACQUIRE, "agent");
            asm volatile("s_waitcnt vmcnt(0)" ::: "memory");
        }
    }
    __syncthreads();
}

__global__ void __launch_bounds__(NTHREADS, 2) fwd_megakernel(Params p) {
    extern __shared__ __attribute__((aligned(16))) unsigned char lds_raw[];
    LAS unsigned char* lds = (LAS unsigned char*)lds_raw;
    cg::grid_group grid = cg::this_grid();
    const int tid = threadIdx.x, lane = tid & 63, wave = __builtin_amdgcn_readfirstlane(tid >> 6);
    const int G = gridDim.x, bid = blockIdx.x, gw = bid * NWAVES + wave, NGW = G * NWAVES;
    unsigned char* ws = p.ws;
    const int lo = p.ph_lo, hi = p.ph_hi;
#define IN(k) (lo <= (k) && (k) < hi)
    volatile LAS unsigned* xbst = (volatile LAS unsigned*)(lds + LDS_BYTES - 16);
    if (tid == 0) { xbst[0] = 0u; xbst[1] = 0u; xbst[2] = 0u; xbst[3] = 0u; }
    __syncthreads();
    const XcdBarrier xbar = xcd_barrier_post((unsigned*)(ws + WS_BAR), xbst, (unsigned)G);
    const bool split_in = (G == 256);
    XcdBarrier tbar = xbar;
    if (split_in) tbar = xcd_barrier_post((unsigned*)(ws + WS_BAR) + 8192 + 4096 * (bid & 1), xbst + 2, (unsigned)(G / 2));
    if (lo < 0) grid.sync();
#define SYNC(k) do { if (IN(k) && IN((k) + 1)) xcd_barrier(xbar); } while (0)

    if (IN(0)) phase0(p, lds, gw, NGW, wave, lane, split_in ? 224 : 320);
    SYNC(0);
    if (IN(1)) {
        const int team = bid & 1, tb = bid >> 1, ntb = (G + 1 - team) >> 1;
        constexpr int I_OUT = 128 * 64;
        bf16_t* WOUTT = (bf16_t*)(ws + WS_WOUTT);
        if (team == 1) {
            if (split_in) { transpose_slice<false>(p.w_in, INC, (bf16_t*)(ws + WS_WINT), 64, 96, 224, lds, 0, 64 * 96, tb * NWAVES + wave, ntb * NWAVES, wave, lane); xcd_barrier(tbar); }
            transpose_slice<true>(p.w_out, DM, WOUTT, 128, 64, 0, lds, 0, split_in ? 2 * I_OUT / 8 : I_OUT / 2, tb * NWAVES + wave, ntb * NWAVES, wave, lane); __syncthreads();
        }
        ProbIn P{(const char*)(ws + WS_HN), (const char*)(ws + WS_WINT), DM, 64, DM / 64, 128, 32768};
        pg8::StaticOrder S; S.init(SEQ / 256, INC / 256, G, bid);
        EpiProj E{(bf16_t*)(ws + WS_PROJ), (float*)(ws + WS_LNS)};
        pg8::gemm_phase<true>(lds, P, S, E);
        if (team == 0) {
            if (split_in) { xcd_barrier(tbar); conv_items(p, tb * NWAVES + wave, ntb * NWAVES, lane); }
            __syncthreads(); transpose_slice<true>(p.w_out, DM, WOUTT, 128, 64, 0, lds, split_in ? 2 * I_OUT / 8 : I_OUT / 2, I_OUT, tb * NWAVES + wave, ntb * NWAVES, wave, lane); }
    }
    SYNC(1);
    if (!split_in) { if (IN(2)) conv_items(p, gw, NGW, lane); SYNC(2); }
    if (IN(3)) {
        ProbGate P{(const char*)(ws + WS_XC), (const char*)(ws + WS_WGT), WA, 256, 4, 128, 128};
        pg8::StaticOrder S; S.init(SEQ / 256, 32, G, bid);
        EpiGate E{(const bf16_t*)(ws + WS_XC), p.b_gate_a, p.b_gate_x, (const float*)(ws + WS_SP8), (bf16_t*)(ws + WS_LOGA), (bf16_t*)(ws + WS_INP)};
        pg8::gemm_phase<true>(lds, P, S, E);
        asm volatile("s_waitcnt vmcnt(0)" ::: "memory"); __syncthreads();
        { Unit u; for (int j = wave; S.next(j >> 1, u); j += NWAVES) scan1_item(p, (2 * u.pm + (j & 1)) * 32 + u.pn, lane); }
        stats_rows(p, gw, NGW, lane);
    }
    SYNC(3);
    if (IN(5)) { scan2_phase(p, gw, NGW, lane); spatial_phase(p, lds, bid, G, tid, wave, lane); }
    if (IN(5) && IN(6)) xcd_barrier(xbar);
    const bool fuse_final = (G == 256);
    if (IN(6)) {
        ProbOut P{(const char*)(ws + WS_MIXED), (const char*)(ws + WS_WOUTT), 64, 64, MIXW / 64, 32768, 32768};
        if (fuse_final) {
            OrderPanel S{bid};
            EpiOutFused E{p.x, p.out, (float*)(ws + WS_SS), (unsigned*)(ws + WS_BAR) + 4096, p.final_g};
            pg8::gemm_phase<false>(lds, P, S, E);
        } else {
            pg8::StaticOrder S; S.init(SEQ / 256, DM / 256, G, bid);
            EpiOut E{p.x, p.out, (float*)(ws + WS_SS)};
            pg8::gemm_phase<false>(lds, P, S, E);
        }
    }
    if (!fuse_final) {
        SYNC(6);
        if (IN(7)) final_phase(p, gw, NGW, lane);
    }
#undef IN
#undef SYNC
}

extern "C" void kernel_launch(void* const* d_in, const int* in_sizes, int n_in, void* d_out, int out_size, void* d_ws, size_t ws_size, hipStream_t stream) {
    static int grid_blocks = 0;
    if (!grid_blocks) {
        int dev = 0, cus = 0, per_cu = 0;
        hipGetDevice(&dev);
        hipDeviceGetAttribute(&cus, hipDeviceAttributeMultiprocessorCount, dev);
        hipFuncSetAttribute((const void*)fwd_megakernel, hipFuncAttributeMaxDynamicSharedMemorySize, LDS_BYTES);
        hipOccupancyMaxActiveBlocksPerMultiprocessor(&per_cu, (const void*)fwd_megakernel, NTHREADS, LDS_BYTES);
        if (per_cu < 1) { fprintf(stderr, "occupancy query says %d blocks per CU\n", per_cu); per_cu = 1; }
        (void)hipGetLastError();
        grid_blocks = cus * 1;
        if (ws_size < WS_END) fprintf(stderr, "workspace too small: %zu < %zu\n", ws_size, (size_t)WS_END);
    }
    Params p{};
    p.x = (const float*)d_in[0]; p.norm_g = (const float*)d_in[1]; p.w_in = (const float*)d_in[2]; p.conv_w = (const float*)d_in[3]; p.conv_b = (const float*)d_in[4];
    p.w_gate_a = (const float*)d_in[5]; p.b_gate_a = (const float*)d_in[6]; p.w_gate_x = (const float*)d_in[7]; p.b_gate_x = (const float*)d_in[8]; p.lru_lambda = (const float*)d_in[9];
    p.ln_v_g = (const float*)d_in[10]; p.ln_v_b = (const float*)d_in[11]; p.w_spatial = (const float*)d_in[12]; p.b_spatial = (const float*)d_in[13]; p.w_out = (const float*)d_in[14]; p.final_g = (const float*)d_in[15];
    p.out = (float*)d_out; p.ws = (unsigned char*)d_ws; p.ph_lo = 0; p.ph_hi = 8;
    hipMemsetAsync((char*)d_ws + WS_BAR, 0, BAR_BYTES, stream);
    void* args[] = {&p};
    hipError_t e = hipLaunchCooperativeKernel((const void*)fwd_megakernel, dim3(grid_blocks), dim3(NTHREADS), args, LDS_BYTES, stream);
    if (e != hipSuccess) fprintf(stderr, "cooperative launch failed: %s (grid %d)\n", hipGetErrorString(e), grid_blocks);
}
```

```cpp
#include <hip/hip_runtime.h>
#include <hip/hip_cooperative_groups.h>
#include <cstdio>
namespace cg = cooperative_groups;

#define LAS __attribute__((address_space(3)))
typedef unsigned short bf16_t;
typedef short bf16x8 __attribute__((ext_vector_type(8)));
typedef float f32x4 __attribute__((ext_vector_type(4)));
typedef float f32x2 __attribute__((ext_vector_type(2)));
typedef unsigned u32x4 __attribute__((ext_vector_type(4)));
typedef unsigned u32x2 __attribute__((ext_vector_type(2)));

constexpr int SEQ = 8192, DM = 4096, INC = 20480, MIXW = 8192, WA = 4096, WB = 4096;
constexpr int NTHREADS = 512, NWAVES = 8;
constexpr int LDS_BYTES = 136 * 1024;
constexpr float EPS = 1e-6f;

constexpr size_t WS_WINT = 0;
constexpr size_t WS_WOUTT = WS_WINT + (size_t)INC * DM * 2;
constexpr size_t WS_WGT = WS_WOUTT + (size_t)DM * MIXW * 2;
constexpr size_t WS_WSP = WS_WGT + (size_t)32 * 256 * 256 * 2;
constexpr size_t WS_SP8 = WS_WSP + (size_t)16 * 128 * 128 * 2;
constexpr size_t WS_HN = WS_SP8 + (size_t)4096 * 4;
constexpr size_t WS_PROJ = WS_HN + (size_t)SEQ * DM * 2;
constexpr size_t WS_XC = WS_PROJ + (size_t)SEQ * INC * 2;
constexpr size_t WS_LNS = WS_XC + (size_t)SEQ * WA * 2;
constexpr size_t WS_STAT = WS_LNS + (size_t)SEQ * 64 * 2 * 4;
constexpr size_t WS_LOGA = WS_STAT + (size_t)SEQ * 2 * 4;
constexpr size_t WS_INP = WS_LOGA + (size_t)SEQ * WA * 2;
constexpr size_t WS_MIXED = WS_INP + (size_t)SEQ * WA * 2;
constexpr size_t WS_P = WS_MIXED + (size_t)SEQ * MIXW * 2;
constexpr size_t WS_HEND = WS_P + (size_t)64 * 4096 * 4;
constexpr size_t WS_SS = WS_HEND + (size_t)64 * 4096 * 4;
constexpr size_t WS_BAR = WS_SS + (size_t)SEQ * 64 * 4;
constexpr size_t BAR_BYTES = 65536;
constexpr size_t WS_END = WS_BAR + BAR_BYTES;

constexpr size_t SEGE = (size_t)SEQ * 4096;
constexpr size_t OFF_XA = 0, OFF_GA = SEGE, OFF_U = 2 * SEGE, OFF_V = 3 * SEGE, OFF_GB = 4 * SEGE;
struct Params {
    const float *x, *norm_g, *w_in, *conv_w, *conv_b, *w_gate_a, *b_gate_a, *w_gate_x, *b_gate_x, *lru_lambda, *ln_v_g, *ln_v_b, *w_spatial, *b_spatial, *w_out, *final_g;
    float* out; unsigned char* ws;
    int ph_lo, ph_hi;
};

__device__ __forceinline__ unsigned pk2(float lo, float hi) { unsigned r; asm("v_cvt_pk_bf16_f32 %0, %1, %2" : "=v"(r) : "v"(lo), "v"(hi)); return r; }
__device__ __forceinline__ float bflo(unsigned w) { return __uint_as_float(w << 16); }
__device__ __forceinline__ float bfhi(unsigned w) { return __uint_as_float(w & 0xffff0000u); }
__device__ __forceinline__ float wave_sum(float v) {
#pragma unroll
    for (int o = 1; o < 64; o <<= 1) v += __shfl_xor(v, o);
    return v;
}
__device__ __forceinline__ float fast_sigmoid(float x) { return __builtin_amdgcn_rcpf(1.0f + __builtin_amdgcn_exp2f(-1.4426950408889634f * x)); }
__device__ __forceinline__ float silu_f(float x) { return x * fast_sigmoid(x); }
__device__ __forceinline__ f32x2 gelu_pk(f32x2 v) {
    const f32x2 av = __builtin_elementwise_abs(v), d = av * 0.2316418882f + 1.0f;
    f32x2 t; t.x = __builtin_amdgcn_rcpf(d.x); t.y = __builtin_amdgcn_rcpf(d.y);
    f32x2 q = t * 0.5307027145f + (-0.7265760135f); q = q * t + 0.7107068705f; q = q * t + (-0.142248368f); q = q * t + 0.127414796f; q = q * t;
    const f32x2 s = (v * v) * (-0.72134752044f);
    f32x2 e; e.x = __builtin_amdgcn_exp2f(s.x); e.y = __builtin_amdgcn_exp2f(s.y);
    const f32x2 m = v * (q * e), r = v - m;
    f32x2 o; o.x = v.x < 0.f ? m.x : r.x; o.y = v.y < 0.f ? m.y : r.y; return o;
}
#define LDS_WAIT() asm volatile("s_waitcnt lgkmcnt(0)" ::: "memory")

namespace pg8 {
constexpr int BM = 256, BK = 64, HALF = 128, HTB = HALF * BK * 2, STAGE_BYTES = 8 * HTB, NXCD = 8, WGM = 8;
__host__ __device__ __forceinline__ int lds_byte(int r, int c) { const int st = (r >> 4) * 2 + (c >> 5), rr = r & 15, cc = c & 31, ob = rr * 64 + cc * 2; return st * 1024 + (ob ^ (((ob >> 9) & 1) << 5)); }
__host__ __device__ __forceinline__ void stage_rc(int b, int& R, int& C) { const int st = b / 1024, sb = b % 1024, swz = sb ^ (((sb >> 9) & 1) << 5); R = (st >> 1) * 16 + swz / 64; C = (st & 1) * 32 + (swz % 64) / 2; }
__host__ __device__ __forceinline__ int perm32(int rho) { const int n = rho >> 4, i = rho & 15; return 8 * (i >> 2) + 4 * n + (i & 3); }
struct Unit { int pm, pn; };
struct StaticOrder {
    int nM, nN, nwg, G, c;
    __device__ void init(int nM_, int nN_, int G_, int c_) { nM = nM_; nN = nN_; nwg = nM * nN; G = G_; c = c_; }
    __device__ bool next(int i, Unit& u) const {
        const long L = (long)i * G + c; if (L >= nwg) return false;
        int wgid = (int)L; { const int q = nwg / NXCD, r = nwg % NXCD, xcd = wgid % NXCD, off = wgid / NXCD; wgid = (xcd < r ? xcd * (q + 1) : r * (q + 1) + (xcd - r) * q) + off; }
        const int nig = WGM * nN, gid = wgid / nig, fm = gid * WGM, gsz = (nM - fm) < WGM ? (nM - fm) : WGM;
        u.pm = fm + ((wgid % nig) % gsz); u.pn = (wgid % nig) / gsz; return true;
    }
};

template <bool PERM, class Prob, class Order, class Epi>
__device__ __forceinline__ void gemm_phase(LAS unsigned char* lds, const Prob& P, const Order& S, const Epi& E) {
    const int tid = threadIdx.x, wid = __builtin_amdgcn_readfirstlane(tid >> 6), lane = tid & 63, wr = wid >> 2, wc = wid & 3, fr = lane & 15, fq = lane >> 4;
    const int nt = P.nt;
    unsigned voffA[2], voffB[2];
#pragma unroll
    for (int i = 0; i < 2; ++i) { int R, C; stage_rc(tid * 16 + i * 8192, R, C); const int Rb = PERM ? ((R & ~31) + perm32(R & 31)) : R;
        voffA[i] = (unsigned)(R * P.lda + C) * 2u; voffB[i] = (unsigned)(Rb * P.ldb + C) * 2u; }
    const size_t kstepA = (size_t)P.kstepA, kstepB = (size_t)P.kstepB;
    const size_t hstepA = (size_t)HALF * P.lda * 2, hstepB = (size_t)HALF * P.ldb * 2;
    const unsigned ldsw = (unsigned)wid * 1024u;
    const int aoff = lds_byte(wr * 64 + fr, fq * 8), boff = lds_byte(wc * 32 + fr, fq * 8);
#define PG8_SA(b, h) (((b) * 2 + (h)) * HTB)
#define PG8_SB(b, h) ((4 + (b) * 2 + (h)) * HTB)
#define PG8_STAGE(bufoff, gbase, voff) do { _Pragma("unroll") for (int _i = 0; _i < 2; ++_i) \
        __builtin_amdgcn_global_load_lds((const unsigned*)((const char*)(gbase) + (voff)[_i]), (LAS unsigned*)(lds + (bufoff) + ldsw + _i * 8192), 16, 0, 0); } while (0)
#define PG8_LDA(dst, b, h) do { _Pragma("unroll") for (int m = 0; m < 4; ++m) _Pragma("unroll") for (int k = 0; k < 2; ++k) dst[m][k] = *(const LAS bf16x8*)(lds + PG8_SA(b, h) + aoff + m * 2048 + k * 1024); } while (0)
#define PG8_LDB(dst, b, h) do { _Pragma("unroll") for (int n = 0; n < 2; ++n) _Pragma("unroll") for (int k = 0; k < 2; ++k) dst[n][k] = *(const LAS bf16x8*)(lds + PG8_SB(b, h) + boff + n * 2048 + k * 1024); } while (0)
#define PG8_MMA(ai, bj, At, Bt) do { __builtin_amdgcn_s_setprio(1); _Pragma("unroll") for (int m = 0; m < 4; ++m) _Pragma("unroll") for (int n = 0; n < 2; ++n) _Pragma("unroll") for (int k = 0; k < 2; ++k) \
        acc[ai][bj][m][n] = __builtin_amdgcn_mfma_f32_16x16x32_bf16(Bt[n][k], At[m][k], acc[ai][bj][m][n], 0, 0, 0); __builtin_amdgcn_s_setprio(0); } while (0)
#define PG8_WAIT_V(n) asm volatile("s_waitcnt vmcnt(" #n ")" ::: "memory")
#define PG8_WAIT_L(n) asm volatile("s_waitcnt lgkmcnt(" #n ")" ::: "memory")
#define PG8_BAR __builtin_amdgcn_s_barrier()
#define PG8_SCHED __builtin_amdgcn_sched_barrier(0)
    Unit cur, nxt; int ui = 0;
    if (!S.next(0, cur)) return;
    f32x4 acc[2][2][4][2];
#pragma unroll
    for (int a = 0; a < 2; ++a)
#pragma unroll
        for (int b = 0; b < 2; ++b)
#pragma unroll
            for (int m = 0; m < 4; ++m)
#pragma unroll
                for (int n = 0; n < 2; ++n) acc[a][b][m][n] = (f32x4){0.f, 0.f, 0.f, 0.f};
    bf16x8 At[4][2], B0[2][2], B1[2][2];
    const char* cA = P.abase(cur); const char* cB = P.bbase(cur);
    PG8_STAGE(PG8_SB(0, 0), cB, voffB); PG8_STAGE(PG8_SA(0, 0), cA, voffA); PG8_STAGE(PG8_SB(0, 1), cB + hstepB, voffB); PG8_STAGE(PG8_SA(0, 1), cA + hstepA, voffA);
    if (wr == 1) PG8_BAR;
    PG8_WAIT_V(4); PG8_BAR;
    PG8_STAGE(PG8_SB(1, 0), cB + kstepB, voffB); PG8_STAGE(PG8_SA(1, 0), cA + kstepA, voffA); PG8_STAGE(PG8_SB(1, 1), cB + hstepB + kstepB, voffB);
    PG8_WAIT_V(6); PG8_BAR;
    for (;;) {
        const bool has_next = S.next(ui + 1, nxt);
        const char* nA = has_next ? P.abase(nxt) : cA; const char* nB = has_next ? P.bbase(nxt) : cB;
        for (int t = 0; t < nt; t += 2) {
            const bool last = (t == nt - 2);
            const char* a1 = cA + (size_t)(t + 1) * kstepA;
            const char* a2 = last ? nA : cA + (size_t)(t + 2) * kstepA; const char* b2 = last ? nB : cB + (size_t)(t + 2) * kstepB;
            const char* a3 = a2 + kstepA; const char* b3 = b2 + kstepB;
            PG8_LDB(B0, 0, 0); PG8_SCHED; PG8_LDA(At, 0, 0); PG8_STAGE(PG8_SA(1, 1), a1 + hstepA, voffA);
            PG8_WAIT_L(8); PG8_BAR; PG8_WAIT_L(0); PG8_MMA(0, 0, At, B0); PG8_BAR; PG8_SCHED;
            PG8_LDB(B1, 0, 1); PG8_STAGE(PG8_SB(0, 0), b2, voffB);
            PG8_BAR; PG8_WAIT_L(0); PG8_MMA(0, 1, At, B1); PG8_BAR;
            PG8_LDA(At, 0, 1); PG8_STAGE(PG8_SA(0, 0), a2, voffA);
            PG8_BAR; PG8_WAIT_L(0); PG8_MMA(1, 0, At, B0); PG8_BAR; PG8_SCHED;
            PG8_STAGE(PG8_SB(0, 1), b2 + hstepB, voffB);
            PG8_WAIT_V(6); PG8_BAR; PG8_MMA(1, 1, At, B1); PG8_BAR;
            PG8_LDB(B0, 1, 0); PG8_SCHED; PG8_LDA(At, 1, 0); PG8_STAGE(PG8_SA(0, 1), a2 + hstepA, voffA);
            PG8_WAIT_L(8); PG8_BAR; PG8_WAIT_L(0); PG8_MMA(0, 0, At, B0); PG8_BAR; PG8_SCHED;
            PG8_LDB(B1, 1, 1); PG8_STAGE(PG8_SB(1, 0), b3, voffB);
            PG8_BAR; PG8_WAIT_L(0); PG8_MMA(0, 1, At, B1); PG8_BAR;
            PG8_LDA(At, 1, 1); PG8_STAGE(PG8_SA(1, 0), a3, voffA);
            PG8_BAR; PG8_WAIT_L(0); PG8_MMA(1, 0, At, B0); PG8_BAR; PG8_SCHED;
            PG8_STAGE(PG8_SB(1, 1), b3 + hstepB, voffB);
            PG8_WAIT_V(6); PG8_BAR; PG8_MMA(1, 1, At, B1); PG8_BAR;
        }
        E(acc, cur, wr, wc, fr, fq);
        if (!has_next) break;
#pragma unroll
        for (int a = 0; a < 2; ++a)
#pragma unroll
            for (int b = 0; b < 2; ++b)
#pragma unroll
                for (int m = 0; m < 4; ++m)
#pragma unroll
                    for (int n = 0; n < 2; ++n) acc[a][b][m][n] = (f32x4){0.f, 0.f, 0.f, 0.f};
        cur = nxt; cA = nA; cB = nB; ++ui;
    }
    PG8_WAIT_V(0);
    if (wr == 0) PG8_BAR;
    PG8_BAR;
#undef PG8_SA
#undef PG8_SB
#undef PG8_STAGE
#undef PG8_LDA
#undef PG8_LDB
#undef PG8_MMA
#undef PG8_WAIT_V
#undef PG8_WAIT_L
#undef PG8_BAR
#undef PG8_SCHED
}
}
using pg8::Unit;

struct ProbIn {
    const char* A; const char* B; int lda, ldb, nt, kstepA, kstepB;
    __device__ __forceinline__ const char* abase(const Unit& u) const { return A + (size_t)u.pm * 256 * 4096 * 2; }
    __device__ __forceinline__ const char* bbase(const Unit& u) const { return B + (size_t)u.pn * 256 * 4096 * 2; }
};
struct ProbGate {
    const char* A; const char* B; int lda, ldb, nt, kstepA, kstepB;
    __device__ __forceinline__ const char* abase(const Unit& u) const { return A + ((size_t)u.pm * 256 * 4096 + (size_t)(u.pn >> 1) * 256) * 2; }
    __device__ __forceinline__ const char* bbase(const Unit& u) const { return B + (size_t)u.pn * 256 * 256 * 2; }
};
struct ProbOut {
    const char* A; const char* B; int lda, ldb, nt, kstepA, kstepB;
    __device__ __forceinline__ const char* abase(const Unit& u) const { return A + (size_t)u.pm * 256 * 8192 * 2; }
    __device__ __forceinline__ const char* bbase(const Unit& u) const { return B + (size_t)u.pn * 256 * 8192 * 2; }
};

struct EpiProj {
    bf16_t* O; float* LNS;
    template <int ACT, bool STATS> __device__ __forceinline__ void body(const f32x4 (&acc)[2][2][4][2], const Unit& u, int wr, int wc, int fr, int fq) const {
        const int row0 = u.pm * 256 + wr * 64 + fr;
        const int seg = u.pn >> 4, pl = u.pn & 15, cin = wc * 32 + 8 * fq;
        bf16_t* B; size_t SN; int SR, SB;
        if (seg == 0) { B = O + OFF_XA + pl * 256 + cin; SN = (size_t)128 * 4096; SR = 4096; SB = 128; }
        else if (seg == 1) { B = O + OFF_GA + (size_t)(pl * 2) * 128 * 128 + cin; SN = (size_t)32 * 128 * 128; SR = 128; SB = 128 * 128; }
        else { B = O + OFF_U + (size_t)(seg - 2) * SEGE + (size_t)pl * 128 * 256 + cin; SN = (size_t)16 * 128 * 256; SR = 256; SB = 128; }
#pragma unroll
        for (int ai = 0; ai < 2; ++ai)
#pragma unroll
            for (int m = 0; m < 4; ++m) { const int row = row0 + ai * 128 + m * 16; bf16_t* rowp = B + (size_t)(2 * u.pm + ai) * SN + (size_t)(wr * 64 + m * 16 + fr) * SR; float s1 = 0.f, s2 = 0.f;
#pragma unroll
                for (int bj = 0; bj < 2; ++bj) { f32x4 v0 = acc[ai][bj][m][0], v1 = acc[ai][bj][m][1];
                    if (ACT == 1) {
#pragma unroll
                        for (int j = 0; j < 4; ++j) { v0[j] = silu_f(v0[j]); v1[j] = silu_f(v1[j]); } }
                    if (ACT == 2) { f32x2 a = gelu_pk((f32x2){v0[0], v0[1]}), b = gelu_pk((f32x2){v0[2], v0[3]}), c = gelu_pk((f32x2){v1[0], v1[1]}), d = gelu_pk((f32x2){v1[2], v1[3]});
                        v0 = (f32x4){a.x, a.y, b.x, b.y}; v1 = (f32x4){c.x, c.y, d.x, d.y}; }
                    if (STATS) { s1 += ((v0[0] + v0[1]) + (v0[2] + v0[3])) + ((v1[0] + v1[1]) + (v1[2] + v1[3]));
                        s2 += ((v0[0] * v0[0] + v0[1] * v0[1]) + (v0[2] * v0[2] + v0[3] * v0[3])) + ((v1[0] * v1[0] + v1[1] * v1[1]) + (v1[2] * v1[2] + v1[3] * v1[3])); }
                    u32x4 w; w.x = pk2(v0[0], v0[1]); w.y = pk2(v0[2], v0[3]); w.z = pk2(v1[0], v1[1]); w.w = pk2(v1[2], v1[3]);
                    *(u32x4*)(rowp + bj * SB) = w; }
                if (STATS) { s1 += __shfl_xor(s1, 16); s1 += __shfl_xor(s1, 32); s2 += __shfl_xor(s2, 16); s2 += __shfl_xor(s2, 32);
                    if (fq == 0) *(f32x2*)(LNS + ((size_t)row * 64 + (u.pn & 15) * 4 + wc) * 2) = (f32x2){s1, s2}; } }
    }
    __device__ __forceinline__ void operator()(const f32x4 (&acc)[2][2][4][2], const Unit& u, int wr, int wc, int fr, int fq) const {
        const int seg = u.pn >> 4;
        if (seg == 3) body<2, true>(acc, u, wr, wc, fr, fq);
        else body<0, false>(acc, u, wr, wc, fr, fq);
    }
};
struct EpiGate {
    const bf16_t* XC; const float* ba; const float* bx; const float* sp8; bf16_t* LOGA; bf16_t* INP;
    __device__ __forceinline__ void operator()(const f32x4 (&acc)[2][2][4][2], const Unit& u, int wr, int wc, int fr, int fq) const {
        const int cb = (u.pn >> 1) * 256 + (u.pn & 1) * 128 + wc * 32 + 8 * fq;
        float bav[8], bxv[8], spv[8];
        { const f32x4 t0 = *(const f32x4*)(ba + cb), t1 = *(const f32x4*)(ba + cb + 4), t2 = *(const f32x4*)(bx + cb), t3 = *(const f32x4*)(bx + cb + 4), t4 = *(const f32x4*)(sp8 + cb), t5 = *(const f32x4*)(sp8 + cb + 4);
#pragma unroll
          for (int j = 0; j < 4; ++j) { bav[j] = t0[j]; bav[4 + j] = t1[j]; bxv[j] = t2[j]; bxv[4 + j] = t3[j]; spv[j] = t4[j]; spv[4 + j] = t5[j]; } }
        u32x4 xwv[2][4];
#pragma unroll
        for (int ai = 0; ai < 2; ++ai)
#pragma unroll
            for (int m = 0; m < 4; ++m) xwv[ai][m] = __builtin_nontemporal_load((const u32x4*)(XC + (size_t)(u.pm * 256 + ai * 128 + wr * 64 + m * 16 + fr) * WA + cb));
#pragma unroll
        for (int ai = 0; ai < 2; ++ai)
#pragma unroll
            for (int m = 0; m < 4; ++m) {
                const size_t off = (size_t)(u.pm * 256 + ai * 128 + wr * 64 + m * 16 + fr) * WA + cb;
                const u32x4 xw = xwv[ai][m];
                float xc[8] = {bflo(xw.x), bfhi(xw.x), bflo(xw.y), bfhi(xw.y), bflo(xw.z), bfhi(xw.z), bflo(xw.w), bfhi(xw.w)};
                float la[8], ip[8];
#pragma unroll
                for (int e = 0; e < 8; e += 2) { const int n = e >> 2, j = e & 3;
                    const f32x2 zr = ((f32x2){acc[ai][0][m][n][j], acc[ai][0][m][n][j + 1]} + (f32x2){bav[e], bav[e + 1]}) * (-1.4426950408889634f);
                    const f32x2 zi = ((f32x2){acc[ai][1][m][n][j], acc[ai][1][m][n][j + 1]} + (f32x2){bxv[e], bxv[e + 1]}) * (-1.4426950408889634f);
                    const f32x2 dr = (f32x2){__builtin_amdgcn_exp2f(zr.x), __builtin_amdgcn_exp2f(zr.y)} + 1.0f, di = (f32x2){__builtin_amdgcn_exp2f(zi.x), __builtin_amdgcn_exp2f(zi.y)} + 1.0f;
                    const f32x2 r = (f32x2){__builtin_amdgcn_rcpf(dr.x), __builtin_amdgcn_rcpf(dr.y)}, ig = (f32x2){__builtin_amdgcn_rcpf(di.x), __builtin_amdgcn_rcpf(di.y)};
                    const f32x2 l = r * (f32x2){-spv[e], -spv[e + 1]};
                    const f32x2 z2 = l * (2.0f * 1.4426950408889634f);
                    const f32x2 om = 1.0f - (f32x2){__builtin_amdgcn_exp2f(z2.x), __builtin_amdgcn_exp2f(z2.y)};
                    const f32x2 sq = (f32x2){__builtin_sqrtf(fmaxf(om.x, 0.f)), __builtin_sqrtf(fmaxf(om.y, 0.f))};
                    const f32x2 o = sq * ig * (f32x2){xc[e], xc[e + 1]};
                    la[e] = l.x; la[e + 1] = l.y; ip[e] = o.x; ip[e + 1] = o.y; }
                u32x4 w0, w1; w0.x = pk2(la[0], la[1]); w0.y = pk2(la[2], la[3]); w0.z = pk2(la[4], la[5]); w0.w = pk2(la[6], la[7]);
                w1.x = pk2(ip[0], ip[1]); w1.y = pk2(ip[2], ip[3]); w1.z = pk2(ip[4], ip[5]); w1.w = pk2(ip[6], ip[7]);
                const size_t toff = ((size_t)((2 * u.pm + ai) * 32 + u.pn) * 128 + (wr * 64 + m * 16 + fr)) * 128 + wc * 32 + 8 * fq;
                *(u32x4*)(LOGA + toff) = w0; *(u32x4*)(INP + toff) = w1;
            }
    }
};
struct EpiOut {
    const float* X; float* O; float* SS;
    __device__ __forceinline__ void operator()(const f32x4 (&acc)[2][2][4][2], const Unit& u, int wr, int wc, int fr, int fq) const {
        const int row0 = u.pm * 256 + wr * 64 + fr, col0 = u.pn * 256 + wc * 32 + 4 * fq;
#pragma unroll
        for (int ai = 0; ai < 2; ++ai)
#pragma unroll
            for (int m = 0; m < 4; ++m) { const int row = row0 + ai * 128 + m * 16; const size_t off = (size_t)row * DM + col0; float ss = 0.f;
#pragma unroll
                for (int bj = 0; bj < 2; ++bj)
#pragma unroll
                    for (int n = 0; n < 2; ++n) { const f32x4 xv = *(const f32x4*)(X + off + bj * 128 + n * 16); const f32x4 o = xv + acc[ai][bj][m][n];
                        ss += (o[0] * o[0] + o[1] * o[1]) + (o[2] * o[2] + o[3] * o[3]); *(f32x4*)(O + off + bj * 128 + n * 16) = o; }
                ss += __shfl_xor(ss, 16); ss += __shfl_xor(ss, 32);
                if (fq == 0) SS[(size_t)row * 64 + u.pn * 4 + wc] = ss; }
    }
};

struct OrderPanel {
    int c;
    __device__ bool next(int i, Unit& u) const { if (i >= 2) return false; const int x = c & 7, j = c >> 3; u.pm = 16 * i + 4 * (x >> 1) + (j >> 3); u.pn = 8 * (x & 1) + (j & 7); return true; }
};
struct EpiOutFused {
    const float* X; float* O; float* SS; unsigned* CNT; const float* FG;
    __device__ __forceinline__ void operator()(f32x4 (&acc)[2][2][4][2], const Unit& u, int wr, int wc, int fr, int fq) const {
        const int row0 = u.pm * 256 + wr * 64 + fr, col0 = u.pn * 256 + wc * 32 + 4 * fq;
#pragma unroll
        for (int ai = 0; ai < 2; ++ai)
#pragma unroll
            for (int m = 0; m < 4; ++m) { const int row = row0 + ai * 128 + m * 16; const size_t off = (size_t)row * DM + col0; float ss = 0.f;
#pragma unroll
                for (int bj = 0; bj < 2; ++bj)
#pragma unroll
                    for (int n = 0; n < 2; ++n) { const f32x4 xv = __builtin_nontemporal_load((const f32x4*)(X + off + bj * 128 + n * 16)); const f32x4 o = xv + acc[ai][bj][m][n]; acc[ai][bj][m][n] = o;
                        ss += (o[0] * o[0] + o[1] * o[1]) + (o[2] * o[2] + o[3] * o[3]); }
                ss += __shfl_xor(ss, 16); ss += __shfl_xor(ss, 32);
                if (fq == 0) __hip_atomic_store((unsigned*)(SS + (size_t)row * 64 + u.pn * 4 + wc), __float_as_uint(ss), __ATOMIC_RELAXED, __HIP_MEMORY_SCOPE_AGENT); }
        asm volatile("s_waitcnt vmcnt(0)" ::: "memory");
        unsigned* cnt = CNT + 64 * u.pm;
        if ((threadIdx.x & 63) == 0) __hip_atomic_fetch_add(cnt, 1u, __ATOMIC_RELAXED, __HIP_MEMORY_SCOPE_AGENT);
        asm volatile("" ::: "memory"); __builtin_amdgcn_s_barrier(); asm volatile("" ::: "memory");
        { unsigned sp = 0;
          while ((unsigned)__builtin_amdgcn_readfirstlane(__hip_atomic_load(cnt, __ATOMIC_RELAXED, __HIP_MEMORY_SCOPE_AGENT)) < 128u) { __builtin_amdgcn_s_sleep(2); if (++sp > (1u << 20)) break; } }
        __builtin_amdgcn_fence(__ATOMIC_ACQUIRE, "agent");
        asm volatile("s_waitcnt vmcnt(0)" ::: "memory");
        f32x4 gv[2][2];
#pragma unroll
        for (int bj = 0; bj < 2; ++bj)
#pragma unroll
            for (int n = 0; n < 2; ++n) gv[bj][n] = *(const f32x4*)(FG + col0 + bj * 128 + n * 16);
#pragma unroll
        for (int ai = 0; ai < 2; ++ai)
#pragma unroll
            for (int m = 0; m < 4; ++m) { const int row = row0 + ai * 128 + m * 16; const f32x4* sp4 = (const f32x4*)(SS + (size_t)row * 64);
                const f32x4 a = sp4[fq], b = sp4[fq + 4], c = sp4[fq + 8], d = sp4[fq + 12];
                float t = ((a[0] + a[1]) + (a[2] + a[3])) + ((b[0] + b[1]) + (b[2] + b[3])) + ((c[0] + c[1]) + (c[2] + c[3])) + ((d[0] + d[1]) + (d[2] + d[3]));
                t += __shfl_xor(t, 16); t += __shfl_xor(t, 32);
                const float rstd = 1.0f / sqrtf(t * (1.0f / DM) + EPS); const size_t off = (size_t)row * DM + col0;
#pragma unroll
                for (int bj = 0; bj < 2; ++bj)
#pragma unroll
                    for (int n = 0; n < 2; ++n) __builtin_nontemporal_store(acc[ai][bj][m][n] * rstd * gv[bj][n], (f32x4*)(O + off + bj * 128 + n * 16)); }
    }
};

template <bool NTS> __device__ __forceinline__ void p0_transpose_item(const float* __restrict__ src, int ldw, bf16_t* __restrict__ dst, int ldd, LAS float* scr, int lane) {
    f32x4 v[16];
#pragma unroll
    for (int i = 0; i < 16; ++i) v[i] = __builtin_nontemporal_load((const f32x4*)(src + (size_t)(4 * i + (lane >> 4)) * ldw + (lane & 15) * 4));
#pragma unroll
    for (int i = 0; i < 16; ++i) { LAS float* p = scr + (4 * i + (lane >> 4)) * 65 + (lane & 15) * 4; p[0] = v[i].x; p[1] = v[i].y; p[2] = v[i].z; p[3] = v[i].w; }
    LDS_WAIT();
    const int c = lane & 7;
#pragma unroll
    for (int j = 0; j < 8; ++j) { const int n = (lane >> 3) + 8 * j; const LAS float* s = scr + (8 * c) * 65 + n;
        u32x4 o; o.x = pk2(s[0 * 65], s[1 * 65]); o.y = pk2(s[2 * 65], s[3 * 65]); o.z = pk2(s[4 * 65], s[5 * 65]); o.w = pk2(s[6 * 65], s[7 * 65]);
        if (NTS) __builtin_nontemporal_store(o, (u32x4*)(dst + (size_t)n * ldd + 8 * c)); else *(u32x4*)(dst + (size_t)n * ldd + 8 * c) = o; }
    LDS_WAIT();
}

__device__ __forceinline__ void phase0(const Params& p, LAS unsigned char* lds, int gw, int NGW, int wave, int lane, int nbk  ) {
    unsigned char* ws = p.ws;
    bf16_t* WINT = (bf16_t*)(ws + WS_WINT); bf16_t* WOUTT = (bf16_t*)(ws + WS_WOUTT); bf16_t* WGT = (bf16_t*)(ws + WS_WGT); bf16_t* WSP = (bf16_t*)(ws + WS_WSP);
    float* SP8 = (float*)(ws + WS_SP8); bf16_t* HN = (bf16_t*)(ws + WS_HN);
    LAS float* scr = (LAS float*)(lds + wave * (64 * 65 * 4));
    const int I_IN = 64 * nbk; constexpr int I_G = 2 * 16 * 16;
    for (int it = gw; it < I_IN + I_G; it += NGW) {
        int r = it;
        if (r < I_IN) { const int kb = r / nbk, nb = r % nbk; p0_transpose_item<false>(p.w_in + (size_t)(64 * kb) * INC + 64 * nb, INC, WINT + ((size_t)((nb >> 2) * 64 + kb) * 256 + (nb & 3) * 64) * 64, 64, scr, lane); continue; }
        r -= I_IN;
        { const int mat = r >> 8, h = (r >> 4) & 15, kb = (r >> 2) & 3, nb = r & 3; const int n0 = 64 * nb, k0 = 64 * kb;
          const float* src = (mat ? p.w_gate_x : p.w_gate_a) + (size_t)h * 65536 + (size_t)k0 * 256 + n0;
          bf16_t* dst = WGT + (size_t)((h * 2 + (n0 >> 7)) * 256 + mat * 128 + (n0 & 127)) * 256 + k0;
          p0_transpose_item<false>(src, 256, dst, 256, scr, lane); }
    }
    const int gt = gw * 64 + lane, NGT = NGW * 64;
    for (int i = gt; i < 16 * 128 * 128; i += NGT) { const int ii = (i >> 7) & 127, jj = i & 127; const float v = ((jj >> 6) <= (ii >> 6)) ? p.w_spatial[i] : 0.f; WSP[i] = (bf16_t)(pk2(v, 0.f) & 0xffffu); }
    for (int i = gt; i < 4096; i += NGT) { const float l = -p.lru_lambda[i]; const float sp = (l > 20.f) ? l : log1pf(__expf(l)); SP8[i] = 8.0f * sp; }
    for (int row = gw; row < SEQ; row += NGW) {
        const f32x4* xr = (const f32x4*)(p.x + (size_t)row * DM) + lane; const f32x4* gr = (const f32x4*)p.norm_g + lane;
        f32x4 v[16]; float s = 0.f;
#pragma unroll
        for (int j = 0; j < 16; ++j) { v[j] = __builtin_nontemporal_load(xr + 64 * j); s += (v[j].x * v[j].x + v[j].y * v[j].y) + (v[j].z * v[j].z + v[j].w * v[j].w); }
        const float rstd = 1.0f / sqrtf(wave_sum(s) * (1.0f / DM) + EPS);
        u32x2* o = (u32x2*)(HN + (size_t)row * DM) + lane;
#pragma unroll
        for (int j = 0; j < 16; ++j) { const f32x4 g = gr[64 * j]; u32x2 w; w.x = pk2(v[j].x * rstd * g.x, v[j].y * rstd * g.y); w.y = pk2(v[j].z * rstd * g.z, v[j].w * rstd * g.w); o[64 * j] = w; }
    }
}

__device__ __forceinline__ void stats_rows(const Params& p, int gw, int NGW, int lane) {
    unsigned char* ws = p.ws;
    { const float* LNS = (const float*)(ws + WS_LNS); float* STAT = (float*)(ws + WS_STAT);
      for (int row = gw; row < SEQ; row += NGW) { const f32x2 pr = *(const f32x2*)(LNS + ((size_t)row * 64 + lane) * 2);
          const float s1 = wave_sum(pr.x), s2 = wave_sum(pr.y); const float mean = s1 * (1.0f / WB); const float var = fmaxf(s2 * (1.0f / WB) - mean * mean, 0.f);
          if (lane == 0) *(f32x2*)(STAT + (size_t)row * 2) = (f32x2){mean, 1.0f / sqrtf(var + EPS)}; } }
}

template <bool NTS> __device__ __forceinline__ void transpose_slice(const float* W, int ldw, bf16_t* WT, int ntk  , int nbw, int nb0, LAS unsigned char* lds, int it0, int it1, int w, int nw, int wave, int lane) {
    LAS float* scr = (LAS float*)(lds + wave * (64 * 65 * 4));
    f32x4 v[16];
    int r = it0 + w;
    if (r < it1) { const float* src = W + (size_t)(64 * (r / nbw)) * ldw + 64 * (nb0 + r % nbw);
#pragma unroll
        for (int i = 0; i < 16; ++i) v[i] = __builtin_nontemporal_load((const f32x4*)(src + (size_t)(4 * i + (lane >> 4)) * ldw + (lane & 15) * 4)); }
    while (r < it1) {
        const int kb = r / nbw, nb = nb0 + r % nbw; bf16_t* dst = WT + ((size_t)((nb >> 2) * ntk + kb) * 256 + (nb & 3) * 64) * 64; constexpr int ldd = 64;
#pragma unroll
        for (int i = 0; i < 16; ++i) { LAS float* q = scr + (4 * i + (lane >> 4)) * 65 + (lane & 15) * 4; q[0] = v[i].x; q[1] = v[i].y; q[2] = v[i].z; q[3] = v[i].w; }
        r += nw;
        if (r < it1) { const float* src = W + (size_t)(64 * (r / nbw)) * ldw + 64 * (nb0 + r % nbw);
#pragma unroll
            for (int i = 0; i < 16; ++i) v[i] = __builtin_nontemporal_load((const f32x4*)(src + (size_t)(4 * i + (lane >> 4)) * ldw + (lane & 15) * 4)); }
        LDS_WAIT();
        const int c = lane & 7;
#pragma unroll
        for (int j = 0; j < 8; ++j) { const int n = (lane >> 3) + 8 * j; const LAS float* sq = scr + (8 * c) * 65 + n;
            u32x4 o; o.x = pk2(sq[0 * 65], sq[1 * 65]); o.y = pk2(sq[2 * 65], sq[3 * 65]); o.z = pk2(sq[4 * 65], sq[5 * 65]); o.w = pk2(sq[6 * 65], sq[7 * 65]);
            if (NTS) __builtin_nontemporal_store(o, (u32x4*)(dst + (size_t)n * ldd + 8 * c)); else *(u32x4*)(dst + (size_t)n * ldd + 8 * c) = o; }
        LDS_WAIT();
    }
}

__device__ __forceinline__ void unpack8(const u32x4 w, float (&f)[8]) { f[0] = bflo(w.x); f[1] = bfhi(w.x); f[2] = bflo(w.y); f[3] = bfhi(w.y); f[4] = bflo(w.z); f[5] = bfhi(w.z); f[6] = bflo(w.w); f[7] = bfhi(w.w); }
__device__ __forceinline__ u32x4 pack8(const float (&f)[8]) { u32x4 w; w.x = pk2(f[0], f[1]); w.y = pk2(f[2], f[3]); w.z = pk2(f[4], f[5]); w.w = pk2(f[6], f[7]); return w; }

__device__ __forceinline__ void conv_items(const Params& p, int gw, int NGW, int lane) {
    unsigned char* ws = p.ws;
    const bf16_t* PROJ = (const bf16_t*)(ws + WS_PROJ); bf16_t* XC = (bf16_t*)(ws + WS_XC);
    for (int it = gw; it < 512 * 8; it += NGW) {
        const int rb = it >> 3, cs = it & 7, t0 = rb * 16, c0 = cs * 512 + lane * 8;
        float w[4][8], b[8];
#pragma unroll
        for (int k = 0; k < 4; ++k) { const f32x4 a = *(const f32x4*)(p.conv_w + k * WA + c0), bb = *(const f32x4*)(p.conv_w + k * WA + c0 + 4);
#pragma unroll
            for (int j = 0; j < 4; ++j) { w[k][j] = a[j]; w[k][4 + j] = bb[j]; } }
        { const f32x4 a = *(const f32x4*)(p.conv_b + c0), bb = *(const f32x4*)(p.conv_b + c0 + 4);
#pragma unroll
          for (int j = 0; j < 4; ++j) { b[j] = a[j]; b[4 + j] = bb[j]; } }
        u32x4 rows[19];
#pragma unroll
        for (int i = 0; i < 19; ++i) { const int t = t0 - 3 + i; rows[i] = (t >= 0) ? __builtin_nontemporal_load((const u32x4*)(PROJ + OFF_XA + (size_t)t * 4096 + c0)) : (u32x4){0u, 0u, 0u, 0u}; }
#pragma unroll
        for (int i = 0; i < 16; ++i) { float x0[8], x1[8], x2[8], x3[8], o[8];
            unpack8(rows[i], x0); unpack8(rows[i + 1], x1); unpack8(rows[i + 2], x2); unpack8(rows[i + 3], x3);
#pragma unroll
            for (int e = 0; e < 8; ++e) o[e] = b[e] + x0[e] * w[0][e] + x1[e] * w[1][e] + x2[e] * w[2][e] + x3[e] * w[3][e];
            *(u32x4*)(XC + (size_t)(t0 + i) * WA + c0) = pack8(o); }
    }
}


constexpr int VT_PITCH = 528, WS_PITCH = 272, VT_BYTES = 128 * VT_PITCH, WL_BYTES = 128 * WS_PITCH;
constexpr int SP_STAT = VT_BYTES + WL_BYTES, SP_BSP = SP_STAT + 2 * 128 * 8, SP_LNG = SP_BSP + 128 * 4, SP_LNB = SP_LNG + 256 * 4;
__device__ __forceinline__ void spatial_phase(const Params& p, LAS unsigned char* lds, int bid, int G, int tid, int wave, int lane) {
    unsigned char* ws = p.ws;
    const bf16_t* PROJ = (const bf16_t*)(ws + WS_PROJ); const float* STAT = (const float*)(ws + WS_STAT); const bf16_t* WSP = (const bf16_t*)(ws + WS_WSP); bf16_t* MIXED = (bf16_t*)(ws + WS_MIXED);
    LAS unsigned char* vt = lds; LAS unsigned char* wl = lds + VT_BYTES;
    LAS f32x2* statbuf = (LAS f32x2*)(lds + SP_STAT); LAS float* bsp = (LAS float*)(lds + SP_BSP); LAS float* lng = (LAS float*)(lds + SP_LNG); LAS float* lnb = (LAS float*)(lds + SP_LNB);
    const int r = lane & 15, q = lane >> 4;
    const int srow = tid >> 5, sch = tid & 31;
    constexpr int NIT = 64 * 16;
    u32x4 vraw[8]; f32x2 stn = (f32x2){0.f, 0.f};
    int cur_g = -1, par = 0;
    int it = bid;
    __syncthreads();
    if (it < NIT) { const int t0 = (it >> 4) * 128;
#pragma unroll
        for (int e = 0; e < 8; ++e) vraw[e] = __builtin_nontemporal_load((const u32x4*)(PROJ + OFF_V + ((size_t)it * 128 + srow + 16 * e) * 256 + sch * 8));
        if (tid < 128) statbuf[tid] = *(const f32x2*)(STAT + (size_t)(t0 + tid) * 2); }
    for (; it < NIT; it += G, par ^= 1) {
        const int n = it >> 4, g = it & 15, t0 = n * 128, cb = g * 256;
        const bool has_next = (it + G < NIT);
        __syncthreads();
        if (g != cur_g) { cur_g = g;
#pragma unroll
            for (int e = 0; e < 4; ++e) { const int pc = tid + 512 * e, row = pc >> 4, ch = pc & 15;
                *(LAS u32x4*)(wl + row * WS_PITCH + ch * 16) = *(const u32x4*)(WSP + (size_t)g * 16384 + row * 128 + ch * 8); }
            if (tid < 128) bsp[tid] = p.b_spatial[g * 128 + tid];
            if (tid < 256) { lng[tid] = p.ln_v_g[cb + tid]; lnb[tid] = p.ln_v_b[cb + tid]; }
            __syncthreads(); }
        { const f32x4 g0 = *(const LAS f32x4*)(lng + sch * 8), g1 = *(const LAS f32x4*)(lng + sch * 8 + 4), b0 = *(const LAS f32x4*)(lnb + sch * 8), b1 = *(const LAS f32x4*)(lnb + sch * 8 + 4);
#pragma unroll
          for (int e = 0; e < 8; ++e) { float x[8]; unpack8(vraw[e], x); const f32x2 st = statbuf[par * 128 + srow + 16 * e];
#pragma unroll
            for (int j = 0; j < 4; ++j) { x[j] = (x[j] - st.x) * st.y * g0[j] + b0[j]; x[4 + j] = (x[4 + j] - st.x) * st.y * g1[j] + b1[j]; }
            *(LAS u32x4*)(vt + (srow + 16 * e) * VT_PITCH + sch * 16) = pack8(x); } }
        u32x4 uu[4], gg[4];
#pragma unroll
        for (int i = 0; i < 4; ++i) { const size_t o = ((size_t)it * 128 + 16 * i + r) * 256 + 32 * wave + 8 * q; uu[i] = __builtin_nontemporal_load((const u32x4*)(PROJ + OFF_U + o)); gg[i] = __builtin_nontemporal_load((const u32x4*)(PROJ + OFF_GB + o)); }
        if (has_next) { const int nt0 = ((it + G) >> 4) * 128;
#pragma unroll
            for (int e = 0; e < 8; ++e) vraw[e] = __builtin_nontemporal_load((const u32x4*)(PROJ + OFF_V + ((size_t)(it + G) * 128 + srow + 16 * e) * 256 + sch * 8));
            if (tid < 128) stn = *(const f32x2*)(STAT + (size_t)(nt0 + tid) * 2); }
        __syncthreads();
        f32x4 acc[2][8];
#pragma unroll
        for (int dt = 0; dt < 2; ++dt)
#pragma unroll
            for (int i = 0; i < 8; ++i) acc[dt][i] = (f32x4){0.f, 0.f, 0.f, 0.f};
#pragma unroll
        for (int ks = 0; ks < 4; ++ks) {
            bf16x8 af[2];
#pragma unroll
            for (int dt = 0; dt < 2; ++dt) { const int chl = 32 * wave + 8 * (r >> 2) + 4 * dt + (r & 3);
#pragma unroll
                for (int e = 0; e < 8; ++e) af[dt][e] = (short)*(const LAS unsigned short*)(vt + (ks * 32 + 8 * q + e) * VT_PITCH + chl * 2); }
#pragma unroll
            for (int i = 0; i < 8; ++i) { if (i < 4 && ks >= 2) continue;
                const bf16x8 bfr = *(const LAS bf16x8*)(wl + (16 * i + r) * WS_PITCH + (ks * 32 + 8 * q) * 2);
#pragma unroll
                for (int dt = 0; dt < 2; ++dt) acc[dt][i] = __builtin_amdgcn_mfma_f32_16x16x32_bf16(af[dt], bfr, acc[dt][i], 0, 0, 0); }
        }
        u32x4 uu2[4], gg2[4];
#pragma unroll
        for (int i = 0; i < 4; ++i) { const size_t o = ((size_t)it * 128 + 16 * (i + 4) + r) * 256 + 32 * wave + 8 * q; uu2[i] = __builtin_nontemporal_load((const u32x4*)(PROJ + OFF_U + o)); gg2[i] = __builtin_nontemporal_load((const u32x4*)(PROJ + OFF_GB + o)); }
#pragma unroll
        for (int i = 0; i < 8; ++i) { const int t = t0 + 16 * i + r; const int ch = cb + 32 * wave + 8 * q;
            const float bs = bsp[16 * i + r];
            float u8[8], g8[8], o[8];
            unpack8(i < 4 ? uu[i & 3] : uu2[i & 3], u8); unpack8(i < 4 ? gg[i & 3] : gg2[i & 3], g8);
#pragma unroll
            for (int e = 0; e < 8; e += 2) { const f32x2 gl = gelu_pk((f32x2){u8[e], u8[e + 1]}); u8[e] = gl.x; u8[e + 1] = gl.y; }
#pragma unroll
            for (int e = 0; e < 8; ++e) o[e] = u8[e] * (acc[e >> 2][i][e & 3] + bs) * silu_f(g8[e]);
            *(u32x4*)(MIXED + ((size_t)((t >> 8) * 128 + ((4096 + ch) >> 6)) * 256 + (t & 255)) * 64 + (ch & 63)) = pack8(o);
            __builtin_amdgcn_sched_barrier(0); }
        if (has_next && tid < 128) statbuf[(par ^ 1) * 128 + tid] = stn;
    }
}

__device__ __forceinline__ void scan1_item(const Params& p, int it, int lane) {
    unsigned char* ws = p.ws;
    const unsigned* LOGA = (const unsigned*)(ws + WS_LOGA); const unsigned* INP = (const unsigned*)(ws + WS_INP);
    float* PP = (float*)(ws + WS_P); float* HE = (float*)(ws + WS_HEND);
    {
        const int k = it >> 5, s = it & 31; const size_t base = (size_t)it * (128 * 64) + lane;
        float h0 = 0.f, h1 = 0.f, l0 = 0.f, l1 = 0.f;
#pragma unroll 1
        for (int tb = 0; tb < 128; tb += 16) {
            unsigned la[16], ip[16];
#pragma unroll
            for (int i = 0; i < 16; ++i) { la[i] = LOGA[base + (size_t)(tb + i) * 64]; ip[i] = INP[base + (size_t)(tb + i) * 64]; }
#pragma unroll
            for (int i = 0; i < 16; ++i) { const float a0 = bflo(la[i]), a1 = bfhi(la[i]); l0 += a0; l1 += a1;
                h0 = __builtin_amdgcn_exp2f(1.4426950408889634f * a0) * h0 + bflo(ip[i]); h1 = __builtin_amdgcn_exp2f(1.4426950408889634f * a1) * h1 + bfhi(ip[i]); }
        }
        const int c = s * 128 + lane * 2;
        *(f32x2*)(PP + (size_t)k * WA + c) = (f32x2){__builtin_amdgcn_exp2f(1.4426950408889634f * l0), __builtin_amdgcn_exp2f(1.4426950408889634f * l1)};
        *(f32x2*)(HE + (size_t)k * WA + c) = (f32x2){h0, h1};
    }
}
__device__ __forceinline__ void scan1_phase(const Params& p, int gw, int NGW, int lane) { for (int it = gw; it < 64 * 32; it += NGW) scan1_item(p, it, lane); }
__device__ __forceinline__ void scan2_phase(const Params& p, int gw, int NGW, int lane) {
    unsigned char* ws = p.ws;
    const unsigned* LOGA = (const unsigned*)(ws + WS_LOGA); const unsigned* INP = (const unsigned*)(ws + WS_INP); const unsigned* PROJ = (const unsigned*)(ws + WS_PROJ);
    const float* PP = (const float*)(ws + WS_P); const float* HE = (const float*)(ws + WS_HEND); unsigned* MIXED = (unsigned*)(ws + WS_MIXED);
    for (int it = gw; it < 64 * 32; it += NGW) {
        const int k = it >> 5, s = it & 31; const int c = s * 128 + lane * 2;
        float h0 = 0.f, h1 = 0.f;
        for (int kb = 0; kb < k; kb += 16) { f32x2 pp[16], he[16];
#pragma unroll
            for (int j = 0; j < 16; ++j) { const int kk = (kb + j) & 63; pp[j] = *(const f32x2*)(PP + (size_t)kk * WA + c); he[j] = *(const f32x2*)(HE + (size_t)kk * WA + c); }
#pragma unroll
            for (int j = 0; j < 16; ++j) { const bool on = (kb + j) < k; const float p0 = on ? pp[j].x : 1.f, p1 = on ? pp[j].y : 1.f, e0 = on ? he[j].x : 0.f, e1 = on ? he[j].y : 0.f; h0 = p0 * h0 + e0; h1 = p1 * h1 + e1; } }
        const size_t base = (size_t)it * (128 * 64) + lane;
#pragma unroll 1
        for (int tb = 0; tb < 128; tb += 16) {
            unsigned la[16], ip[16], ga[16];
#pragma unroll
            for (int i = 0; i < 16; ++i) { la[i] = __builtin_nontemporal_load(LOGA + base + (size_t)(tb + i) * 64); ip[i] = __builtin_nontemporal_load(INP + base + (size_t)(tb + i) * 64);
                ga[i] = __builtin_nontemporal_load(PROJ + OFF_GA / 2 + base + (size_t)(tb + i) * 64); }
#pragma unroll
            for (int i = 0; i < 16; ++i) { const float a0 = bflo(la[i]), a1 = bfhi(la[i]);
                h0 = __builtin_amdgcn_exp2f(1.4426950408889634f * a0) * h0 + bflo(ip[i]); h1 = __builtin_amdgcn_exp2f(1.4426950408889634f * a1) * h1 + bfhi(ip[i]);
                { const int t = k * 128 + tb + i; MIXED[((size_t)((t >> 8) * 128 + 2 * s + (lane >> 5)) * 256 + (t & 255)) * 32 + (lane & 31)] = pk2(h0 * silu_f(bflo(ga[i])), h1 * silu_f(bfhi(ga[i]))); } }
        }
    }
}

__device__ __forceinline__ void final_phase(const Params& p, int gw, int NGW, int lane) {
    const float* SS = (const float*)(p.ws + WS_SS);
    for (int row = gw; row < SEQ; row += NGW) {
        const float ss = wave_sum(SS[(size_t)row * 64 + lane]);
        const float rstd = 1.0f / sqrtf(ss * (1.0f / DM) + EPS);
        f32x4* xr = (f32x4*)(p.out + (size_t)row * DM) + lane; const f32x4* gr = (const f32x4*)p.final_g + lane;
        f32x4 v[16];
#pragma unroll
        for (int j = 0; j < 16; ++j) v[j] = xr[64 * j];
#pragma unroll
        for (int j = 0; j < 16; ++j) { const f32x4 g = gr[64 * j]; xr[64 * j] = v[j] * rstd * g; }
    }
}

#define XB_TMO      128
#define XB_XCNT(j)  (256  + 64 * (j))
#define XB_XSUB(j)  (1280 + 64 * (j))
#define XB_XGEN(j)  (2304 + 64 * (j))
#define XB_TOP      3328
#define XB_TOPGEN   3392
#define XB_SPIN_CAP (1u << 20)
__device__ __forceinline__ unsigned xb_ld(unsigned* p)              { return __hip_atomic_load(p, __ATOMIC_RELAXED, __HIP_MEMORY_SCOPE_AGENT); }
__device__ __forceinline__ unsigned xb_add(unsigned* p, unsigned v) { return __hip_atomic_fetch_add(p, v, __ATOMIC_RELAXED, __HIP_MEMORY_SCOPE_AGENT); }
__device__ __forceinline__ unsigned xb_xcc_id() { return (unsigned)__builtin_amdgcn_s_getreg((3 << 11) | 20) & 0xFu; }
#define XB_SPIN(cond, bar) do { unsigned _sp = 0; while (cond) { __builtin_amdgcn_s_sleep(1); \
    if ((++_sp & 255u) == 0u) { if (xb_ld(&(bar)[XB_TMO])) break; if (_sp > XB_SPIN_CAP) { atomicAdd(&(bar)[XB_TMO], 1u); break; } } } } while (0)
struct XcdBarrier { unsigned* bar; unsigned x; volatile LAS unsigned* st; unsigned total; };
__device__ __forceinline__ XcdBarrier xcd_barrier_post(unsigned* bar, volatile LAS unsigned* st, unsigned total) {
    XcdBarrier b; b.bar = bar; b.x = xb_xcc_id(); b.st = st; b.total = total;
    if (threadIdx.x == 0) (void)xb_add(&bar[XB_XCNT(b.x)], 1u);
    return b;
}
__device__ __forceinline__ void xcd_barrier_complete(unsigned* bar, unsigned x, unsigned& nloc, unsigned& nx, unsigned G) {
    unsigned sum, cnt, mine, sp = 0u;
    for (;;) {
        sum = 0u; cnt = 0u; mine = 0u;
#pragma unroll
        for (unsigned j = 0; j < 16; ++j) { const unsigned c = xb_ld(&bar[XB_XCNT(j)]); sum += c; cnt += (c > 0u) ? 1u : 0u; mine = (j == x) ? c : mine; }
        if (sum == G) break;
        __builtin_amdgcn_s_sleep(1);
        if ((++sp & 255u) == 0u) { if (xb_ld(&bar[XB_TMO])) break; if (sp > XB_SPIN_CAP) { atomicAdd(&bar[XB_TMO], 1u); break; } }
    }
    nloc = mine > 0u ? mine : 1u; nx = cnt > 0u ? cnt : 1u;
}
__device__ __forceinline__ void xcd_barrier(const XcdBarrier& b) {
    asm volatile("s_waitcnt vmcnt(0)" ::: "memory");
    __syncthreads();
    if (threadIdx.x == 0) {
        unsigned* bar = b.bar;
        __builtin_amdgcn_s_waitcnt(0);
        unsigned nloc = b.st[0], nx = b.st[1];
        if (nloc == 0u) { xcd_barrier_complete(bar, b.x, nloc, nx, b.total); b.st[0] = nloc; b.st[1] = nx; }
        const unsigned old = xb_add(&bar[XB_XSUB(b.x)], 1u);
        const unsigned gen = old / nloc;
        if (old + 1u == (gen + 1u) * nloc) {
            __builtin_amdgcn_fence(__ATOMIC_RELEASE, "agent");
            asm volatile("s_waitcnt vmcnt(0)" ::: "memory");
            const unsigned og = xb_add(&bar[XB_TOP], 1u);
            const unsigned tg = og / nx;
            if (og + 1u == (tg + 1u) * nx) xb_add(&bar[XB_TOPGEN], 1u);
            else XB_SPIN(xb_ld(&bar[XB_TOPGEN]) == tg, bar);
            __builtin_amdgcn_fence(__ATOMIC_ACQUIRE, "agent");
            xb_add(&bar[XB_XGEN(b.x)], 1u);
            asm volatile("s_waitcnt vmcnt(0)" ::: "memory");
        } else {
            XB_SPIN(xb_ld(&bar[XB_XGEN(b.x)]) == gen, bar);
            __builtin_amdgcn_fence(__ATOMIC_ACQUIRE, "agent");
            asm volatile("s_waitcnt vmcnt(0)" ::: "memory");
        }
    }
    __syncthreads();
}

__global__ void __launch_bounds__(NTHREADS, 2) fwd_megakernel(Params p) {
    extern __shared__ __attribute__((aligned(16))) unsigned char lds_raw[];
    LAS unsigned char* lds = (LAS unsigned char*)lds_raw;
    cg::grid_group grid = cg::this_grid();
    const int tid = threadIdx.x, lane = tid & 63, wave = __builtin_amdgcn_readfirstlane(tid >> 6);
    const int G = gridDim.x, bid = blockIdx.x, gw = bid * NWAVES + wave, NGW = G * NWAVES;
    unsigned char* ws = p.ws;
    const int lo = p.ph_lo, hi = p.ph_hi;
#define IN(k) (lo <= (k) && (k) < hi)
    volatile LAS unsigned* xbst = (volatile LAS unsigned*)(lds + LDS_BYTES - 16);
    if (tid == 0) { xbst[0] = 0u; xbst[1] = 0u; xbst[2] = 0u; xbst[3] = 0u; }
    __syncthreads();
    const XcdBarrier xbar = xcd_barrier_post((unsigned*)(ws + WS_BAR), xbst, (unsigned)G);
    const bool split_in = (G == 256);
    XcdBarrier tbar = xbar;
    if (split_in) tbar = xcd_barrier_post((unsigned*)(ws + WS_BAR) + 8192 + 4096 * (bid & 1), xbst + 2, (unsigned)(G / 2));
    if (lo < 0) grid.sync();
#define SYNC(k) do { if (IN(k) && IN((k) + 1)) xcd_barrier(xbar); } while (0)

    if (IN(0)) phase0(p, lds, gw, NGW, wave, lane, split_in ? 224 : 320);
    SYNC(0);
    if (IN(1)) {
        const int team = bid & 1, tb = bid >> 1, ntb = (G + 1 - team) >> 1;
        constexpr int I_OUT = 128 * 64;
        bf16_t* WOUTT = (bf16_t*)(ws + WS_WOUTT);
        if (team == 1) {
            if (split_in) { transpose_slice<false>(p.w_in, INC, (bf16_t*)(ws + WS_WINT), 64, 96, 224, lds, 0, 64 * 96, tb * NWAVES + wave, ntb * NWAVES, wave, lane); xcd_barrier(tbar); }
            transpose_slice<true>(p.w_out, DM, WOUTT, 128, 64, 0, lds, 0, split_in ? 3 * I_OUT / 8 : I_OUT / 2, tb * NWAVES + wave, ntb * NWAVES, wave, lane); __syncthreads();
        }
        ProbIn P{(const char*)(ws + WS_HN), (const char*)(ws + WS_WINT), DM, 64, DM / 64, 128, 32768};
        pg8::StaticOrder S; S.init(SEQ / 256, INC / 256, G, bid);
        EpiProj E{(bf16_t*)(ws + WS_PROJ), (float*)(ws + WS_LNS)};
        pg8::gemm_phase<true>(lds, P, S, E);
        if (team == 0) {
            if (split_in) { xcd_barrier(tbar); conv_items(p, tb * NWAVES + wave, ntb * NWAVES, lane); }
            __syncthreads(); transpose_slice<true>(p.w_out, DM, WOUTT, 128, 64, 0, lds, split_in ? 3 * I_OUT / 8 : I_OUT / 2, I_OUT, tb * NWAVES + wave, ntb * NWAVES, wave, lane); }
    }
    SYNC(1);
    if (!split_in) { if (IN(2)) conv_items(p, gw, NGW, lane); SYNC(2); }
    if (IN(3)) {
        ProbGate P{(const char*)(ws + WS_XC), (const char*)(ws + WS_WGT), WA, 256, 4, 128, 128};
        pg8::StaticOrder S; S.init(SEQ / 256, 32, G, bid);
        EpiGate E{(const bf16_t*)(ws + WS_XC), p.b_gate_a, p.b_gate_x, (const float*)(ws + WS_SP8), (bf16_t*)(ws + WS_LOGA), (bf16_t*)(ws + WS_INP)};
        pg8::gemm_phase<true>(lds, P, S, E);
        asm volatile("s_waitcnt vmcnt(0)" ::: "memory"); __syncthreads();
        { Unit u; for (int j = wave; S.next(j >> 1, u); j += NWAVES) scan1_item(p, (2 * u.pm + (j & 1)) * 32 + u.pn, lane); }
        stats_rows(p, gw, NGW, lane);
    }
    SYNC(3);
    if (IN(5)) { scan2_phase(p, gw, NGW, lane); spatial_phase(p, lds, bid, G, tid, wave, lane); }
    if (IN(5) && IN(6)) xcd_barrier(xbar);
    const bool fuse_final = (G == 256);
    if (IN(6)) {
        ProbOut P{(const char*)(ws + WS_MIXED), (const char*)(ws + WS_WOUTT), 64, 64, MIXW / 64, 32768, 32768};
        if (fuse_final) {
            OrderPanel S{bid};
            EpiOutFused E{p.x, p.out, (float*)(ws + WS_SS), (unsigned*)(ws + WS_BAR) + 4096, p.final_g};
            pg8::gemm_phase<false>(lds, P, S, E);
        } else {
            pg8::StaticOrder S; S.init(SEQ / 256, DM / 256, G, bid);
            EpiOut E{p.x, p.out, (float*)(ws + WS_SS)};
            pg8::gemm_phase<false>(lds, P, S, E);
        }
    }
    if (!fuse_final) {
        SYNC(6);
        if (IN(7)) final_phase(p, gw, NGW, lane);
    }
#undef IN
#undef SYNC
}

extern "C" void kernel_launch(void* const* d_in, const int* in_sizes, int n_in, void* d_out, int out_size, void* d_ws, size_t ws_size, hipStream_t stream) {
    static int grid_blocks = 0;
    if (!grid_blocks) {
        int dev = 0, cus = 0, per_cu = 0;
        hipGetDevice(&dev);
        hipDeviceGetAttribute(&cus, hipDeviceAttributeMultiprocessorCount, dev);
        hipFuncSetAttribute((const void*)fwd_megakernel, hipFuncAttributeMaxDynamicSharedMemorySize, LDS_BYTES);
        hipOccupancyMaxActiveBlocksPerMultiprocessor(&per_cu, (const void*)fwd_megakernel, NTHREADS, LDS_BYTES);
        if (per_cu < 1) { fprintf(stderr, "occupancy query says %d blocks per CU\n", per_cu); per_cu = 1; }
        (void)hipGetLastError();
        grid_blocks = cus * 1;
        if (ws_size < WS_END) fprintf(stderr, "workspace too small: %zu < %zu\n", ws_size, (size_t)WS_END);
    }
    Params p{};
    p.x = (const float*)d_in[0]; p.norm_g = (const float*)d_in[1]; p.w_in = (const float*)d_in[2]; p.conv_w = (const float*)d_in[3]; p.conv_b = (const float*)d_in[4];
    p.w_gate_a = (const float*)d_in[5]; p.b_gate_a = (const float*)d_in[6]; p.w_gate_x = (const float*)d_in[7]; p.b_gate_x = (const float*)d_in[8]; p.lru_lambda = (const float*)d_in[9];
    p.ln_v_g = (const float*)d_in[10]; p.ln_v_b = (const float*)d_in[11]; p.w_spatial = (const float*)d_in[12]; p.b_spatial = (const float*)d_in[13]; p.w_out = (const float*)d_in[14]; p.final_g = (const float*)d_in[15];
    p.out = (float*)d_out; p.ws = (unsigned char*)d_ws; p.ph_lo = 0; p.ph_hi = 8;
    hipMemsetAsync((char*)d_ws + WS_BAR, 0, BAR_BYTES, stream);
    void* args[] = {&p};
    hipError_t e = hipLaunchCooperativeKernel((const void*)fwd_megakernel, dim3(grid_blocks), dim3(NTHREADS), args, LDS_BYTES, stream);
    if (e != hipSuccess) fprintf(stderr, "cooperative launch failed: %s (grid %d)\n", hipGetErrorString(e), grid_blocks);
}
```

```cpp
#include <hip/hip_runtime.h>
#include <hip/hip_cooperative_groups.h>
#include <cstdio>
namespace cg = cooperative_groups;

#define LAS __attribute__((address_space(3)))
typedef unsigned short bf16_t;
typedef short bf16x8 __attribute__((ext_vector_type(8)));
typedef float f32x4 __attribute__((ext_vector_type(4)));
typedef float f32x2 __attribute__((ext_vector_type(2)));
typedef unsigned u32x4 __attribute__((ext_vector_type(4)));
typedef unsigned u32x2 __attribute__((ext_vector_type(2)));

constexpr int SEQ = 8192, DM = 4096, INC = 20480, MIXW = 8192, WA = 4096, WB = 4096;
constexpr int NTHREADS = 512, NWAVES = 8;
constexpr int LDS_BYTES = 136 * 1024;
constexpr float EPS = 1e-6f;

constexpr size_t WS_WINT = 0;
constexpr size_t WS_WOUTT = WS_WINT + (size_t)INC * DM * 2;
constexpr size_t WS_WGT = WS_WOUTT + (size_t)DM * MIXW * 2;
constexpr size_t WS_WSP = WS_WGT + (size_t)32 * 256 * 256 * 2;
constexpr size_t WS_SP8 = WS_WSP + (size_t)16 * 128 * 128 * 2;
constexpr size_t WS_HN = WS_SP8 + (size_t)4096 * 4;
constexpr size_t WS_PROJ = WS_HN + (size_t)SEQ * DM * 2;
constexpr size_t WS_XC = WS_PROJ + (size_t)SEQ * INC * 2;
constexpr size_t WS_LNS = WS_XC + (size_t)SEQ * WA * 2;
constexpr size_t WS_STAT = WS_LNS + (size_t)SEQ * 64 * 2 * 4;
constexpr size_t WS_LOGA = WS_STAT + (size_t)SEQ * 2 * 4;
constexpr size_t WS_INP = WS_LOGA + (size_t)SEQ * WA * 2;
constexpr size_t WS_MIXED = WS_INP + (size_t)SEQ * WA * 2;
constexpr size_t WS_P = WS_MIXED + (size_t)SEQ * MIXW * 2;
constexpr size_t WS_HEND = WS_P + (size_t)64 * 4096 * 4;
constexpr size_t WS_SS = WS_HEND + (size_t)64 * 4096 * 4;
constexpr size_t WS_BAR = WS_SS + (size_t)SEQ * 64 * 4;
constexpr size_t BAR_BYTES = 65536;
constexpr size_t WS_END = WS_BAR + BAR_BYTES;

constexpr size_t SEGE = (size_t)SEQ * 4096;
constexpr size_t OFF_XA = 0, OFF_GA = SEGE, OFF_U = 2 * SEGE, OFF_V = 3 * SEGE, OFF_GB = 4 * SEGE;
struct Params {
    const float *x, *norm_g, *w_in, *conv_w, *conv_b, *w_gate_a, *b_gate_a, *w_gate_x, *b_gate_x, *lru_lambda, *ln_v_g, *ln_v_b, *w_spatial, *b_spatial, *w_out, *final_g;
    float* out; unsigned char* ws;
    int ph_lo, ph_hi;
};

__device__ __forceinline__ unsigned pk2(float lo, float hi) { unsigned r; asm("v_cvt_pk_bf16_f32 %0, %1, %2" : "=v"(r) : "v"(lo), "v"(hi)); return r; }
__device__ __forceinline__ float bflo(unsigned w) { return __uint_as_float(w << 16); }
__device__ __forceinline__ float bfhi(unsigned w) { return __uint_as_float(w & 0xffff0000u); }
__device__ __forceinline__ float wave_sum(float v) {
#pragma unroll
    for (int o = 1; o < 64; o <<= 1) v += __shfl_xor(v, o);
    return v;
}
__device__ __forceinline__ float fast_sigmoid(float x) { return __builtin_amdgcn_rcpf(1.0f + __builtin_amdgcn_exp2f(-1.4426950408889634f * x)); }
__device__ __forceinline__ float silu_f(float x) { return x * fast_sigmoid(x); }
__device__ __forceinline__ f32x2 gelu_pk(f32x2 v) {
    const f32x2 av = __builtin_elementwise_abs(v), d = av * 0.2316418882f + 1.0f;
    f32x2 t; t.x = __builtin_amdgcn_rcpf(d.x); t.y = __builtin_amdgcn_rcpf(d.y);
    f32x2 q = t * 0.5307027145f + (-0.7265760135f); q = q * t + 0.7107068705f; q = q * t + (-0.142248368f); q = q * t + 0.127414796f; q = q * t;
    const f32x2 s = (v * v) * (-0.72134752044f);
    f32x2 e; e.x = __builtin_amdgcn_exp2f(s.x); e.y = __builtin_amdgcn_exp2f(s.y);
    const f32x2 m = v * (q * e), r = v - m;
    f32x2 o; o.x = v.x < 0.f ? m.x : r.x; o.y = v.y < 0.f ? m.y : r.y; return o;
}
#define LDS_WAIT() asm volatile("s_waitcnt lgkmcnt(0)" ::: "memory")

namespace pg8 {
constexpr int BM = 256, BK = 64, HALF = 128, HTB = HALF * BK * 2, STAGE_BYTES = 8 * HTB, NXCD = 8, WGM = 8;
__host__ __device__ __forceinline__ int lds_byte(int r, int c) { const int st = (r >> 4) * 2 + (c >> 5), rr = r & 15, cc = c & 31, ob = rr * 64 + cc * 2; return st * 1024 + (ob ^ (((ob >> 9) & 1) << 5)); }
__host__ __device__ __forceinline__ void stage_rc(int b, int& R, int& C) { const int st = b / 1024, sb = b % 1024, swz = sb ^ (((sb >> 9) & 1) << 5); R = (st >> 1) * 16 + swz / 64; C = (st & 1) * 32 + (swz % 64) / 2; }
__host__ __device__ __forceinline__ int perm32(int rho) { const int n = rho >> 4, i = rho & 15; return 8 * (i >> 2) + 4 * n + (i & 3); }
struct Unit { int pm, pn; };
struct StaticOrder {
    int nM, nN, nwg, G, c;
    __device__ void init(int nM_, int nN_, int G_, int c_) { nM = nM_; nN = nN_; nwg = nM * nN; G = G_; c = c_; }
    __device__ bool next(int i, Unit& u) const {
        const long L = (long)i * G + c; if (L >= nwg) return false;
        int wgid = (int)L; { const int q = nwg / NXCD, r = nwg % NXCD, xcd = wgid % NXCD, off = wgid / NXCD; wgid = (xcd < r ? xcd * (q + 1) : r * (q + 1) + (xcd - r) * q) + off; }
        const int nig = WGM * nN, gid = wgid / nig, fm = gid * WGM, gsz = (nM - fm) < WGM ? (nM - fm) : WGM;
        u.pm = fm + ((wgid % nig) % gsz); u.pn = (wgid % nig) / gsz; return true;
    }
};

template <bool PERM, class Prob, class Order, class Epi>
__device__ __forceinline__ void gemm_phase(LAS unsigned char* lds, const Prob& P, const Order& S, const Epi& E) {
    const int tid = threadIdx.x, wid = __builtin_amdgcn_readfirstlane(tid >> 6), lane = tid & 63, wr = wid >> 2, wc = wid & 3, fr = lane & 15, fq = lane >> 4;
    const int nt = P.nt;
    unsigned voffA[2], voffB[2];
#pragma unroll
    for (int i = 0; i < 2; ++i) { int R, C; stage_rc(tid * 16 + i * 8192, R, C); const int Rb = PERM ? ((R & ~31) + perm32(R & 31)) : R;
        voffA[i] = (unsigned)(R * P.lda + C) * 2u; voffB[i] = (unsigned)(Rb * P.ldb + C) * 2u; }
    const size_t kstepA = (size_t)P.kstepA, kstepB = (size_t)P.kstepB;
    const size_t hstepA = (size_t)HALF * P.lda * 2, hstepB = (size_t)HALF * P.ldb * 2;
    const unsigned ldsw = (unsigned)wid * 1024u;
    const int aoff = lds_byte(wr * 64 + fr, fq * 8), boff = lds_byte(wc * 32 + fr, fq * 8);
#define PG8_SA(b, h) (((b) * 2 + (h)) * HTB)
#define PG8_SB(b, h) ((4 + (b) * 2 + (h)) * HTB)
#define PG8_STAGE(bufoff, gbase, voff) do { _Pragma("unroll") for (int _i = 0; _i < 2; ++_i) \
        __builtin_amdgcn_global_load_lds((const unsigned*)((const char*)(gbase) + (voff)[_i]), (LAS unsigned*)(lds + (bufoff) + ldsw + _i * 8192), 16, 0, 0); } while (0)
#define PG8_LDA(dst, b, h) do { _Pragma("unroll") for (int m = 0; m < 4; ++m) _Pragma("unroll") for (int k = 0; k < 2; ++k) dst[m][k] = *(const LAS bf16x8*)(lds + PG8_SA(b, h) + aoff + m * 2048 + k * 1024); } while (0)
#define PG8_LDB(dst, b, h) do { _Pragma("unroll") for (int n = 0; n < 2; ++n) _Pragma("unroll") for (int k = 0; k < 2; ++k) dst[n][k] = *(const LAS bf16x8*)(lds + PG8_SB(b, h) + boff + n * 2048 + k * 1024); } while (0)
#define PG8_MMA(ai, bj, At, Bt) do { __builtin_amdgcn_s_setprio(1); _Pragma("unroll") for (int m = 0; m < 4; ++m) _Pragma("unroll") for (int n = 0; n < 2; ++n) _Pragma("unroll") for (int k = 0; k < 2; ++k) \
        acc[ai][bj][m][n] = __builtin_amdgcn_mfma_f32_16x16x32_bf16(Bt[n][k], At[m][k], acc[ai][bj][m][n], 0, 0, 0); __builtin_amdgcn_s_setprio(0); } while (0)
#define PG8_WAIT_V(n) asm volatile("s_waitcnt vmcnt(" #n ")" ::: "memory")
#define PG8_WAIT_L(n) asm volatile("s_waitcnt lgkmcnt(" #n ")" ::: "memory")
#define PG8_BAR __builtin_amdgcn_s_barrier()
#define PG8_SCHED __builtin_amdgcn_sched_barrier(0)
    Unit cur, nxt; int ui = 0;
    if (!S.next(0, cur)) return;
    f32x4 acc[2][2][4][2];
#pragma unroll
    for (int a = 0; a < 2; ++a)
#pragma unroll
        for (int b = 0; b < 2; ++b)
#pragma unroll
            for (int m = 0; m < 4; ++m)
#pragma unroll
                for (int n = 0; n < 2; ++n) acc[a][b][m][n] = (f32x4){0.f, 0.f, 0.f, 0.f};
    bf16x8 At[4][2], B0[2][2], B1[2][2];
    const char* cA = P.abase(cur); const char* cB = P.bbase(cur);
    PG8_STAGE(PG8_SB(0, 0), cB, voffB); PG8_STAGE(PG8_SA(0, 0), cA, voffA); PG8_STAGE(PG8_SB(0, 1), cB + hstepB, voffB); PG8_STAGE(PG8_SA(0, 1), cA + hstepA, voffA);
    if (wr == 1) PG8_BAR;
    PG8_WAIT_V(4); PG8_BAR;
    PG8_STAGE(PG8_SB(1, 0), cB + kstepB, voffB); PG8_STAGE(PG8_SA(1, 0), cA + kstepA, voffA); PG8_STAGE(PG8_SB(1, 1), cB + hstepB + kstepB, voffB);
    PG8_WAIT_V(6); PG8_BAR;
    for (;;) {
        const bool has_next = S.next(ui + 1, nxt);
        const char* nA = has_next ? P.abase(nxt) : cA; const char* nB = has_next ? P.bbase(nxt) : cB;
        for (int t = 0; t < nt; t += 2) {
            const bool last = (t == nt - 2);
            const char* a1 = cA + (size_t)(t + 1) * kstepA;
            const char* a2 = last ? nA : cA + (size_t)(t + 2) * kstepA; const char* b2 = last ? nB : cB + (size_t)(t + 2) * kstepB;
            const char* a3 = a2 + kstepA; const char* b3 = b2 + kstepB;
            PG8_LDB(B0, 0, 0); PG8_SCHED; PG8_LDA(At, 0, 0); PG8_STAGE(PG8_SA(1, 1), a1 + hstepA, voffA);
            PG8_WAIT_L(8); PG8_BAR; PG8_WAIT_L(0); PG8_MMA(0, 0, At, B0); PG8_BAR; PG8_SCHED;
            PG8_LDB(B1, 0, 1); PG8_STAGE(PG8_SB(0, 0), b2, voffB);
            PG8_BAR; PG8_WAIT_L(0); PG8_MMA(0, 1, At, B1); PG8_BAR;
            PG8_LDA(At, 0, 1); PG8_STAGE(PG8_SA(0, 0), a2, voffA);
            PG8_BAR; PG8_WAIT_L(0); PG8_MMA(1, 0, At, B0); PG8_BAR; PG8_SCHED;
            PG8_STAGE(PG8_SB(0, 1), b2 + hstepB, voffB);
            PG8_WAIT_V(6); PG8_BAR; PG8_MMA(1, 1, At, B1); PG8_BAR;
            PG8_LDB(B0, 1, 0); PG8_SCHED; PG8_LDA(At, 1, 0); PG8_STAGE(PG8_SA(0, 1), a2 + hstepA, voffA);
            PG8_WAIT_L(8); PG8_BAR; PG8_WAIT_L(0); PG8_MMA(0, 0, At, B0); PG8_BAR; PG8_SCHED;
            PG8_LDB(B1, 1, 1); PG8_STAGE(PG8_SB(1, 0), b3, voffB);
            PG8_BAR; PG8_WAIT_L(0); PG8_MMA(0, 1, At, B1); PG8_BAR;
            PG8_LDA(At, 1, 1); PG8_STAGE(PG8_SA(1, 0), a3, voffA);
            PG8_BAR; PG8_WAIT_L(0); PG8_MMA(1, 0, At, B0); PG8_BAR; PG8_SCHED;
            PG8_STAGE(PG8_SB(1, 1), b3 + hstepB, voffB);
            PG8_WAIT_V(6); PG8_BAR; PG8_MMA(1, 1, At, B1); PG8_BAR;
        }
        E(acc, cur, wr, wc, fr, fq);
        if (!has_next) break;
#pragma unroll
        for (int a = 0; a < 2; ++a)
#pragma unroll
            for (int b = 0; b < 2; ++b)
#pragma unroll
                for (int m = 0; m < 4; ++m)
#pragma unroll
                    for (int n = 0; n < 2; ++n) acc[a][b][m][n] = (f32x4){0.f, 0.f, 0.f, 0.f};
        cur = nxt; cA = nA; cB = nB; ++ui;
    }
    PG8_WAIT_V(0);
    if (wr == 0) PG8_BAR;
    PG8_BAR;
#undef PG8_SA
#undef PG8_SB
#undef PG8_STAGE
#undef PG8_LDA
#undef PG8_LDB
#undef PG8_MMA
#undef PG8_WAIT_V
#undef PG8_WAIT_L
#undef PG8_BAR
#undef PG8_SCHED
}
}
using pg8::Unit;

struct ProbIn {
    const char* A; const char* B; int lda, ldb, nt, kstepA, kstepB;
    __device__ __forceinline__ const char* abase(const Unit& u) const { return A + (size_t)u.pm * 256 * 4096 * 2; }
    __device__ __forceinline__ const char* bbase(const Unit& u) const { return B + (size_t)u.pn * 256 * 4096 * 2; }
};
struct ProbGate {
    const char* A; const char* B; int lda, ldb, nt, kstepA, kstepB;
    __device__ __forceinline__ const char* abase(const Unit& u) const { return A + ((size_t)u.pm * 256 * 4096 + (size_t)(u.pn >> 1) * 256) * 2; }
    __device__ __forceinline__ const char* bbase(const Unit& u) const { return B + (size_t)u.pn * 256 * 256 * 2; }
};
struct ProbOut {
    const char* A; const char* B; int lda, ldb, nt, kstepA, kstepB;
    __device__ __forceinline__ const char* abase(const Unit& u) const { return A + (size_t)u.pm * 256 * 8192 * 2; }
    __device__ __forceinline__ const char* bbase(const Unit& u) const { return B + (size_t)u.pn * 256 * 8192 * 2; }
};

struct EpiProj {
    bf16_t* O; float* LNS;
    template <int ACT, bool STATS> __device__ __forceinline__ void body(const f32x4 (&acc)[2][2][4][2], const Unit& u, int wr, int wc, int fr, int fq) const {
        const int row0 = u.pm * 256 + wr * 64 + fr;
        const int seg = u.pn >> 4, pl = u.pn & 15, cin = wc * 32 + 8 * fq;
        bf16_t* B; size_t SN; int SR, SB;
        if (seg == 0) { B = O + OFF_XA + pl * 256 + cin; SN = (size_t)128 * 4096; SR = 4096; SB = 128; }
        else if (seg == 1) { B = O + OFF_GA + (size_t)(pl * 2) * 128 * 128 + cin; SN = (size_t)32 * 128 * 128; SR = 128; SB = 128 * 128; }
        else { B = O + OFF_U + (size_t)(seg - 2) * SEGE + (size_t)pl * 128 * 256 + cin; SN = (size_t)16 * 128 * 256; SR = 256; SB = 128; }
#pragma unroll
        for (int ai = 0; ai < 2; ++ai)
#pragma unroll
            for (int m = 0; m < 4; ++m) { const int row = row0 + ai * 128 + m * 16; bf16_t* rowp = B + (size_t)(2 * u.pm + ai) * SN + (size_t)(wr * 64 + m * 16 + fr) * SR; float s1 = 0.f, s2 = 0.f;
#pragma unroll
                for (int bj = 0; bj < 2; ++bj) { f32x4 v0 = acc[ai][bj][m][0], v1 = acc[ai][bj][m][1];
                    if (ACT == 1) {
#pragma unroll
                        for (int j = 0; j < 4; ++j) { v0[j] = silu_f(v0[j]); v1[j] = silu_f(v1[j]); } }
                    if (ACT == 2) { f32x2 a = gelu_pk((f32x2){v0[0], v0[1]}), b = gelu_pk((f32x2){v0[2], v0[3]}), c = gelu_pk((f32x2){v1[0], v1[1]}), d = gelu_pk((f32x2){v1[2], v1[3]});
                        v0 = (f32x4){a.x, a.y, b.x, b.y}; v1 = (f32x4){c.x, c.y, d.x, d.y}; }
                    if (STATS) { s1 += ((v0[0] + v0[1]) + (v0[2] + v0[3])) + ((v1[0] + v1[1]) + (v1[2] + v1[3]));
                        s2 += ((v0[0] * v0[0] + v0[1] * v0[1]) + (v0[2] * v0[2] + v0[3] * v0[3])) + ((v1[0] * v1[0] + v1[1] * v1[1]) + (v1[2] * v1[2] + v1[3] * v1[3])); }
                    u32x4 w; w.x = pk2(v0[0], v0[1]); w.y = pk2(v0[2], v0[3]); w.z = pk2(v1[0], v1[1]); w.w = pk2(v1[2], v1[3]);
                    *(u32x4*)(rowp + bj * SB) = w; }
                if (STATS) { s1 += __shfl_xor(s1, 16); s1 += __shfl_xor(s1, 32); s2 += __shfl_xor(s2, 16); s2 += __shfl_xor(s2, 32);
                    if (fq == 0) *(f32x2*)(LNS + ((size_t)row * 64 + (u.pn & 15) * 4 + wc) * 2) = (f32x2){s1, s2}; } }
    }
    __device__ __forceinline__ void operator()(const f32x4 (&acc)[2][2][4][2], const Unit& u, int wr, int wc, int fr, int fq) const {
        const int seg = u.pn >> 4;
        if (seg == 3) body<2, true>(acc, u, wr, wc, fr, fq);
        else body<0, false>(acc, u, wr, wc, fr, fq);
    }
};
struct EpiGate {
    const bf16_t* XC; const float* ba; const float* bx; const float* sp8; bf16_t* LOGA; bf16_t* INP;
    __device__ __forceinline__ void operator()(const f32x4 (&acc)[2][2][4][2], const Unit& u, int wr, int wc, int fr, int fq) const {
        const int cb = (u.pn >> 1) * 256 + (u.pn & 1) * 128 + wc * 32 + 8 * fq;
        float bav[8], bxv[8], spv[8];
        { const f32x4 t0 = *(const f32x4*)(ba + cb), t1 = *(const f32x4*)(ba + cb + 4), t2 = *(const f32x4*)(bx + cb), t3 = *(const f32x4*)(bx + cb + 4), t4 = *(const f32x4*)(sp8 + cb), t5 = *(const f32x4*)(sp8 + cb + 4);
#pragma unroll
          for (int j = 0; j < 4; ++j) { bav[j] = t0[j]; bav[4 + j] = t1[j]; bxv[j] = t2[j]; bxv[4 + j] = t3[j]; spv[j] = t4[j]; spv[4 + j] = t5[j]; } }
        u32x4 xwv[2][4];
#pragma unroll
        for (int ai = 0; ai < 2; ++ai)
#pragma unroll
            for (int m = 0; m < 4; ++m) xwv[ai][m] = __builtin_nontemporal_load((const u32x4*)(XC + (size_t)(u.pm * 256 + ai * 128 + wr * 64 + m * 16 + fr) * WA + cb));
#pragma unroll
        for (int ai = 0; ai < 2; ++ai)
#pragma unroll
            for (int m = 0; m < 4; ++m) {
                const size_t off = (size_t)(u.pm * 256 + ai * 128 + wr * 64 + m * 16 + fr) * WA + cb;
                const u32x4 xw = xwv[ai][m];
                float xc[8] = {bflo(xw.x), bfhi(xw.x), bflo(xw.y), bfhi(xw.y), bflo(xw.z), bfhi(xw.z), bflo(xw.w), bfhi(xw.w)};
                float la[8], ip[8];
#pragma unroll
                for (int e = 0; e < 8; e += 2) { const int n = e >> 2, j = e & 3;
                    const f32x2 zr = ((f32x2){acc[ai][0][m][n][j], acc[ai][0][m][n][j + 1]} + (f32x2){bav[e], bav[e + 1]}) * (-1.4426950408889634f);
                    const f32x2 zi = ((f32x2){acc[ai][1][m][n][j], acc[ai][1][m][n][j + 1]} + (f32x2){bxv[e], bxv[e + 1]}) * (-1.4426950408889634f);
                    const f32x2 dr = (f32x2){__builtin_amdgcn_exp2f(zr.x), __builtin_amdgcn_exp2f(zr.y)} + 1.0f, di = (f32x2){__builtin_amdgcn_exp2f(zi.x), __builtin_amdgcn_exp2f(zi.y)} + 1.0f;
                    const f32x2 r = (f32x2){__builtin_amdgcn_rcpf(dr.x), __builtin_amdgcn_rcpf(dr.y)}, ig = (f32x2){__builtin_amdgcn_rcpf(di.x), __builtin_amdgcn_rcpf(di.y)};
                    const f32x2 l = r * (f32x2){-spv[e], -spv[e + 1]};
                    const f32x2 z2 = l * (2.0f * 1.4426950408889634f);
                    const f32x2 om = 1.0f - (f32x2){__builtin_amdgcn_exp2f(z2.x), __builtin_amdgcn_exp2f(z2.y)};
                    const f32x2 sq = (f32x2){__builtin_sqrtf(fmaxf(om.x, 0.f)), __builtin_sqrtf(fmaxf(om.y, 0.f))};
                    const f32x2 o = sq * ig * (f32x2){xc[e], xc[e + 1]};
                    la[e] = l.x; la[e + 1] = l.y; ip[e] = o.x; ip[e + 1] = o.y; }
                u32x4 w0, w1; w0.x = pk2(la[0], la[1]); w0.y = pk2(la[2], la[3]); w0.z = pk2(la[4], la[5]); w0.w = pk2(la[6], la[7]);
                w1.x = pk2(ip[0], ip[1]); w1.y = pk2(ip[2], ip[3]); w1.z = pk2(ip[4], ip[5]); w1.w = pk2(ip[6], ip[7]);
                const size_t toff = ((size_t)((2 * u.pm + ai) * 32 + u.pn) * 128 + (wr * 64 + m * 16 + fr)) * 128 + wc * 32 + 8 * fq;
                *(u32x4*)(LOGA + toff) = w0; *(u32x4*)(INP + toff) = w1;
            }
    }
};
struct EpiOut {
    const float* X; float* O; float* SS;
    __device__ __forceinline__ void operator()(const f32x4 (&acc)[2][2][4][2], const Unit& u, int wr, int wc, int fr, int fq) const {
        const int row0 = u.pm * 256 + wr * 64 + fr, col0 = u.pn * 256 + wc * 32 + 4 * fq;
#pragma unroll
        for (int ai = 0; ai < 2; ++ai)
#pragma unroll
            for (int m = 0; m < 4; ++m) { const int row = row0 + ai * 128 + m * 16; const size_t off = (size_t)row * DM + col0; float ss = 0.f;
#pragma unroll
                for (int bj = 0; bj < 2; ++bj)
#pragma unroll
                    for (int n = 0; n < 2; ++n) { const f32x4 xv = *(const f32x4*)(X + off + bj * 128 + n * 16); const f32x4 o = xv + acc[ai][bj][m][n];
                        ss += (o[0] * o[0] + o[1] * o[1]) + (o[2] * o[2] + o[3] * o[3]); *(f32x4*)(O + off + bj * 128 + n * 16) = o; }
                ss += __shfl_xor(ss, 16); ss += __shfl_xor(ss, 32);
                if (fq == 0) SS[(size_t)row * 64 + u.pn * 4 + wc] = ss; }
    }
};

struct OrderPanel {
    int c;
    __device__ bool next(int i, Unit& u) const { if (i >= 2) return false; const int x = c & 7, j = c >> 3; u.pm = 16 * i + 4 * (x >> 1) + (j >> 3); u.pn = 8 * (x & 1) + (j & 7); return true; }
};
struct EpiOutFused {
    const float* X; float* O; float* SS; unsigned* CNT; const float* FG;
    __device__ __forceinline__ void operator()(f32x4 (&acc)[2][2][4][2], const Unit& u, int wr, int wc, int fr, int fq) const {
        const int row0 = u.pm * 256 + wr * 64 + fr, col0 = u.pn * 256 + wc * 32 + 4 * fq;
#pragma unroll
        for (int ai = 0; ai < 2; ++ai)
#pragma unroll
            for (int m = 0; m < 4; ++m) { const int row = row0 + ai * 128 + m * 16; const size_t off = (size_t)row * DM + col0; float ss = 0.f;
#pragma unroll
                for (int bj = 0; bj < 2; ++bj)
#pragma unroll
                    for (int n = 0; n < 2; ++n) { const f32x4 xv = __builtin_nontemporal_load((const f32x4*)(X + off + bj * 128 + n * 16)); const f32x4 o = xv + acc[ai][bj][m][n]; acc[ai][bj][m][n] = o;
                        ss += (o[0] * o[0] + o[1] * o[1]) + (o[2] * o[2] + o[3] * o[3]); }
                ss += __shfl_xor(ss, 16); ss += __shfl_xor(ss, 32);
                if (fq == 0) __hip_atomic_store((unsigned*)(SS + (size_t)row * 64 + u.pn * 4 + wc), __float_as_uint(ss), __ATOMIC_RELAXED, __HIP_MEMORY_SCOPE_AGENT); }
        asm volatile("s_waitcnt vmcnt(0)" ::: "memory");
        unsigned* cnt = CNT + 64 * u.pm;
        if ((threadIdx.x & 63) == 0) __hip_atomic_fetch_add(cnt, 1u, __ATOMIC_RELAXED, __HIP_MEMORY_SCOPE_AGENT);
        asm volatile("" ::: "memory"); __builtin_amdgcn_s_barrier(); asm volatile("" ::: "memory");
        { unsigned sp = 0;
          while ((unsigned)__builtin_amdgcn_readfirstlane(__hip_atomic_load(cnt, __ATOMIC_RELAXED, __HIP_MEMORY_SCOPE_AGENT)) < 128u) { __builtin_amdgcn_s_sleep(2); if (++sp > (1u << 20)) break; } }
        __builtin_amdgcn_fence(__ATOMIC_ACQUIRE, "agent");
        asm volatile("s_waitcnt vmcnt(0)" ::: "memory");
        f32x4 gv[2][2];
#pragma unroll
        for (int bj = 0; bj < 2; ++bj)
#pragma unroll
            for (int n = 0; n < 2; ++n) gv[bj][n] = *(const f32x4*)(FG + col0 + bj * 128 + n * 16);
#pragma unroll
        for (int ai = 0; ai < 2; ++ai)
#pragma unroll
            for (int m = 0; m < 4; ++m) { const int row = row0 + ai * 128 + m * 16; const f32x4* sp4 = (const f32x4*)(SS + (size_t)row * 64);
                const f32x4 a = sp4[fq], b = sp4[fq + 4], c = sp4[fq + 8], d = sp4[fq + 12];
                float t = ((a[0] + a[1]) + (a[2] + a[3])) + ((b[0] + b[1]) + (b[2] + b[3])) + ((c[0] + c[1]) + (c[2] + c[3])) + ((d[0] + d[1]) + (d[2] + d[3]));
                t += __shfl_xor(t, 16); t += __shfl_xor(t, 32);
                const float rstd = 1.0f / sqrtf(t * (1.0f / DM) + EPS); const size_t off = (size_t)row * DM + col0;
#pragma unroll
                for (int bj = 0; bj < 2; ++bj)
#pragma unroll
                    for (int n = 0; n < 2; ++n) __builtin_nontemporal_store(acc[ai][bj][m][n] * rstd * gv[bj][n], (f32x4*)(O + off + bj * 128 + n * 16)); }
    }
};

template <bool NTS> __device__ __forceinline__ void p0_transpose_item(const float* __restrict__ src, int ldw, bf16_t* __restrict__ dst, int ldd, LAS float* scr, int lane) {
    f32x4 v[16];
#pragma unroll
    for (int i = 0; i < 16; ++i) v[i] = __builtin_nontemporal_load((const f32x4*)(src + (size_t)(4 * i + (lane >> 4)) * ldw + (lane & 15) * 4));
#pragma unroll
    for (int i = 0; i < 16; ++i) { LAS float* p = scr + (4 * i + (lane >> 4)) * 65 + (lane & 15) * 4; p[0] = v[i].x; p[1] = v[i].y; p[2] = v[i].z; p[3] = v[i].w; }
    LDS_WAIT();
    const int c = lane & 7;
#pragma unroll
    for (int j = 0; j < 8; ++j) { const int n = (lane >> 3) + 8 * j; const LAS float* s = scr + (8 * c) * 65 + n;
        u32x4 o; o.x = pk2(s[0 * 65], s[1 * 65]); o.y = pk2(s[2 * 65], s[3 * 65]); o.z = pk2(s[4 * 65], s[5 * 65]); o.w = pk2(s[6 * 65], s[7 * 65]);
        if (NTS) __builtin_nontemporal_store(o, (u32x4*)(dst + (size_t)n * ldd + 8 * c)); else *(u32x4*)(dst + (size_t)n * ldd + 8 * c) = o; }
    LDS_WAIT();
}

__device__ __forceinline__ void phase0(const Params& p, LAS unsigned char* lds, int gw, int NGW, int wave, int lane, int nbk  ) {
    unsigned char* ws = p.ws;
    bf16_t* WINT = (bf16_t*)(ws + WS_WINT); bf16_t* WOUTT = (bf16_t*)(ws + WS_WOUTT); bf16_t* WGT = (bf16_t*)(ws + WS_WGT); bf16_t* WSP = (bf16_t*)(ws + WS_WSP);
    float* SP8 = (float*)(ws + WS_SP8); bf16_t* HN = (bf16_t*)(ws + WS_HN);
    LAS float* scr = (LAS float*)(lds + wave * (64 * 65 * 4));
    const int I_IN = 64 * nbk; constexpr int I_G = 2 * 16 * 16;
    for (int it = gw; it < I_IN + I_G; it += NGW) {
        int r = it;
        if (r < I_IN) { const int kb = r / nbk, nb = r % nbk; p0_transpose_item<false>(p.w_in + (size_t)(64 * kb) * INC + 64 * nb, INC, WINT + ((size_t)((nb >> 2) * 64 + kb) * 256 + (nb & 3) * 64) * 64, 64, scr, lane); continue; }
        r -= I_IN;
        { const int mat = r >> 8, h = (r >> 4) & 15, kb = (r >> 2) & 3, nb = r & 3; const int n0 = 64 * nb, k0 = 64 * kb;
          const float* src = (mat ? p.w_gate_x : p.w_gate_a) + (size_t)h * 65536 + (size_t)k0 * 256 + n0;
          bf16_t* dst = WGT + (size_t)((h * 2 + (n0 >> 7)) * 256 + mat * 128 + (n0 & 127)) * 256 + k0;
          p0_transpose_item<false>(src, 256, dst, 256, scr, lane); }
    }
    const int gt = gw * 64 + lane, NGT = NGW * 64;
    for (int i = gt; i < 16 * 128 * 128; i += NGT) { const int ii = (i >> 7) & 127, jj = i & 127; const float v = ((jj >> 6) <= (ii >> 6)) ? p.w_spatial[i] : 0.f; WSP[i] = (bf16_t)(pk2(v, 0.f) & 0xffffu); }
    for (int i = gt; i < 4096; i += NGT) { const float l = -p.lru_lambda[i]; const float sp = (l > 20.f) ? l : log1pf(__expf(l)); SP8[i] = 8.0f * sp; }
    for (int row = gw; row < SEQ; row += NGW) {
        const f32x4* xr = (const f32x4*)(p.x + (size_t)row * DM) + lane; const f32x4* gr = (const f32x4*)p.norm_g + lane;
        f32x4 v[16]; float s = 0.f;
#pragma unroll
        for (int j = 0; j < 16; ++j) { v[j] = __builtin_nontemporal_load(xr + 64 * j); s += (v[j].x * v[j].x + v[j].y * v[j].y) + (v[j].z * v[j].z + v[j].w * v[j].w); }
        const float rstd = 1.0f / sqrtf(wave_sum(s) * (1.0f / DM) + EPS);
        u32x2* o = (u32x2*)(HN + (size_t)row * DM) + lane;
#pragma unroll
        for (int j = 0; j < 16; ++j) { const f32x4 g = gr[64 * j]; u32x2 w; w.x = pk2(v[j].x * rstd * g.x, v[j].y * rstd * g.y); w.y = pk2(v[j].z * rstd * g.z, v[j].w * rstd * g.w); o[64 * j] = w; }
    }
}

__device__ __forceinline__ void stats_rows(const Params& p, int gw, int NGW, int lane) {
    unsigned char* ws = p.ws;
    { const float* LNS = (const float*)(ws + WS_LNS); float* STAT = (float*)(ws + WS_STAT);
      for (int row = gw; row < SEQ; row += NGW) { const f32x2 pr = *(const f32x2*)(LNS + ((size_t)row * 64 + lane) * 2);
          const float s1 = wave_sum(pr.x), s2 = wave_sum(pr.y); const float mean = s1 * (1.0f / WB); const float var = fmaxf(s2 * (1.0f / WB) - mean * mean, 0.f);
          if (lane == 0) *(f32x2*)(STAT + (size_t)row * 2) = (f32x2){mean, 1.0f / sqrtf(var + EPS)}; } }
}

template <bool NTS> __device__ __forceinline__ void transpose_slice(const float* W, int ldw, bf16_t* WT, int ntk  , int nbw, int nb0, LAS unsigned char* lds, int it0, int it1, int w, int nw, int wave, int lane) {
    LAS float* scr = (LAS float*)(lds + wave * (64 * 65 * 4));
    f32x4 v[16];
    int r = it0 + w;
    if (r < it1) { const float* src = W + (size_t)(64 * (r / nbw)) * ldw + 64 * (nb0 + r % nbw);
#pragma unroll
        for (int i = 0; i < 16; ++i) v[i] = __builtin_nontemporal_load((const f32x4*)(src + (size_t)(4 * i + (lane >> 4)) * ldw + (lane & 15) * 4)); }
    while (r < it1) {
        const int kb = r / nbw, nb = nb0 + r % nbw; bf16_t* dst = WT + ((size_t)((nb >> 2) * ntk + kb) * 256 + (nb & 3) * 64) * 64; constexpr int ldd = 64;
#pragma unroll
        for (int i = 0; i < 16; ++i) { LAS float* q = scr + (4 * i + (lane >> 4)) * 65 + (lane & 15) * 4; q[0] = v[i].x; q[1] = v[i].y; q[2] = v[i].z; q[3] = v[i].w; }
        r += nw;
        if (r < it1) { const float* src = W + (size_t)(64 * (r / nbw)) * ldw + 64 * (nb0 + r % nbw);
#pragma unroll
            for (int i = 0; i < 16; ++i) v[i] = __builtin_nontemporal_load((const f32x4*)(src + (size_t)(4 * i + (lane >> 4)) * ldw + (lane & 15) * 4)); }
        LDS_WAIT();
        const int c = lane & 7;
#pragma unroll
        for (int j = 0; j < 8; ++j) { const int n = (lane >> 3) + 8 * j; const LAS float* sq = scr + (8 * c) * 65 + n;
            u32x4 o; o.x = pk2(sq[0 * 65], sq[1 * 65]); o.y = pk2(sq[2 * 65], sq[3 * 65]); o.z = pk2(sq[4 * 65], sq[5 * 65]); o.w = pk2(sq[6 * 65], sq[7 * 65]);
            if (NTS) __builtin_nontemporal_store(o, (u32x4*)(dst + (size_t)n * ldd + 8 * c)); else *(u32x4*)(dst + (size_t)n * ldd + 8 * c) = o; }
        LDS_WAIT();
    }
}

__device__ __forceinline__ void unpack8(const u32x4 w, float (&f)[8]) { f[0] = bflo(w.x); f[1] = bfhi(w.x); f[2] = bflo(w.y); f[3] = bfhi(w.y); f[4] = bflo(w.z); f[5] = bfhi(w.z); f[6] = bflo(w.w); f[7] = bfhi(w.w); }
__device__ __forceinline__ u32x4 pack8(const float (&f)[8]) { u32x4 w; w.x = pk2(f[0], f[1]); w.y = pk2(f[2], f[3]); w.z = pk2(f[4], f[5]); w.w = pk2(f[6], f[7]); return w; }

__device__ __forceinline__ void conv_items(const Params& p, int gw, int NGW, int lane) {
    unsigned char* ws = p.ws;
    const bf16_t* PROJ = (const bf16_t*)(ws + WS_PROJ); bf16_t* XC = (bf16_t*)(ws + WS_XC);
    for (int it = gw; it < 512 * 8; it += NGW) {
        const int rb = it >> 3, cs = it & 7, t0 = rb * 16, c0 = cs * 512 + lane * 8;
        float w[4][8], b[8];
#pragma unroll
        for (int k = 0; k < 4; ++k) { const f32x4 a = *(const f32x4*)(p.conv_w + k * WA + c0), bb = *(const f32x4*)(p.conv_w + k * WA + c0 + 4);
#pragma unroll
            for (int j = 0; j < 4; ++j) { w[k][j] = a[j]; w[k][4 + j] = bb[j]; } }
        { const f32x4 a = *(const f32x4*)(p.conv_b + c0), bb = *(const f32x4*)(p.conv_b + c0 + 4);
#pragma unroll
          for (int j = 0; j < 4; ++j) { b[j] = a[j]; b[4 + j] = bb[j]; } }
        u32x4 rows[19];
#pragma unroll
        for (int i = 0; i < 19; ++i) { const int t = t0 - 3 + i; rows[i] = (t >= 0) ? __builtin_nontemporal_load((const u32x4*)(PROJ + OFF_XA + (size_t)t * 4096 + c0)) : (u32x4){0u, 0u, 0u, 0u}; }
#pragma unroll
        for (int i = 0; i < 16; ++i) { float x0[8], x1[8], x2[8], x3[8], o[8];
            unpack8(rows[i], x0); unpack8(rows[i + 1], x1); unpack8(rows[i + 2], x2); unpack8(rows[i + 3], x3);
#pragma unroll
            for (int e = 0; e < 8; ++e) o[e] = b[e] + x0[e] * w[0][e] + x1[e] * w[1][e] + x2[e] * w[2][e] + x3[e] * w[3][e];
            *(u32x4*)(XC + (size_t)(t0 + i) * WA + c0) = pack8(o); }
    }
}


constexpr int VT_PITCH = 528, WS_PITCH = 272, VT_BYTES = 128 * VT_PITCH, WL_BYTES = 128 * WS_PITCH;
constexpr int SP_STAT = VT_BYTES + WL_BYTES, SP_BSP = SP_STAT + 2 * 128 * 8, SP_LNG = SP_BSP + 128 * 4, SP_LNB = SP_LNG + 256 * 4;
__device__ __forceinline__ void spatial_phase(const Params& p, LAS unsigned char* lds, int bid, int G, int tid, int wave, int lane) {
    unsigned char* ws = p.ws;
    const bf16_t* PROJ = (const bf16_t*)(ws + WS_PROJ); const float* STAT = (const float*)(ws + WS_STAT); const bf16_t* WSP = (const bf16_t*)(ws + WS_WSP); bf16_t* MIXED = (bf16_t*)(ws + WS_MIXED);
    LAS unsigned char* vt = lds; LAS unsigned char* wl = lds + VT_BYTES;
    LAS f32x2* statbuf = (LAS f32x2*)(lds + SP_STAT); LAS float* bsp = (LAS float*)(lds + SP_BSP); LAS float* lng = (LAS float*)(lds + SP_LNG); LAS float* lnb = (LAS float*)(lds + SP_LNB);
    const int r = lane & 15, q = lane >> 4;
    const int srow = tid >> 5, sch = tid & 31;
    constexpr int NIT = 64 * 16;
    u32x4 vraw[8]; f32x2 stn = (f32x2){0.f, 0.f};
    int cur_g = -1, par = 0;
    int it = bid;
    __syncthreads();
    if (it < NIT) { const int t0 = (it >> 4) * 128;
#pragma unroll
        for (int e = 0; e < 8; ++e) vraw[e] = __builtin_nontemporal_load((const u32x4*)(PROJ + OFF_V + ((size_t)it * 128 + srow + 16 * e) * 256 + sch * 8));
        if (tid < 128) statbuf[tid] = *(const f32x2*)(STAT + (size_t)(t0 + tid) * 2); }
    for (; it < NIT; it += G, par ^= 1) {
        const int n = it >> 4, g = it & 15, t0 = n * 128, cb = g * 256;
        const bool has_next = (it + G < NIT);
        __syncthreads();
        if (g != cur_g) { cur_g = g;
#pragma unroll
            for (int e = 0; e < 4; ++e) { const int pc = tid + 512 * e, row = pc >> 4, ch = pc & 15;
                *(LAS u32x4*)(wl + row * WS_PITCH + ch * 16) = *(const u32x4*)(WSP + (size_t)g * 16384 + row * 128 + ch * 8); }
            if (tid < 128) bsp[tid] = p.b_spatial[g * 128 + tid];
            if (tid < 256) { lng[tid] = p.ln_v_g[cb + tid]; lnb[tid] = p.ln_v_b[cb + tid]; }
            __syncthreads(); }
        { const f32x4 g0 = *(const LAS f32x4*)(lng + sch * 8), g1 = *(const LAS f32x4*)(lng + sch * 8 + 4), b0 = *(const LAS f32x4*)(lnb + sch * 8), b1 = *(const LAS f32x4*)(lnb + sch * 8 + 4);
#pragma unroll
          for (int e = 0; e < 8; ++e) { float x[8]; unpack8(vraw[e], x); const f32x2 st = statbuf[par * 128 + srow + 16 * e];
#pragma unroll
            for (int j = 0; j < 4; ++j) { x[j] = (x[j] - st.x) * st.y * g0[j] + b0[j]; x[4 + j] = (x[4 + j] - st.x) * st.y * g1[j] + b1[j]; }
            *(LAS u32x4*)(vt + (srow + 16 * e) * VT_PITCH + sch * 16) = pack8(x); } }
        u32x4 uu[4], gg[4];
#pragma unroll
        for (int i = 0; i < 4; ++i) { const size_t o = ((size_t)it * 128 + 16 * i + r) * 256 + 32 * wave + 8 * q; uu[i] = __builtin_nontemporal_load((const u32x4*)(PROJ + OFF_U + o)); gg[i] = __builtin_nontemporal_load((const u32x4*)(PROJ + OFF_GB + o)); }
        if (has_next) { const int nt0 = ((it + G) >> 4) * 128;
#pragma unroll
            for (int e = 0; e < 8; ++e) vraw[e] = __builtin_nontemporal_load((const u32x4*)(PROJ + OFF_V + ((size_t)(it + G) * 128 + srow + 16 * e) * 256 + sch * 8));
            if (tid < 128) stn = *(const f32x2*)(STAT + (size_t)(nt0 + tid) * 2); }
        __syncthreads();
        f32x4 acc[2][8];
#pragma unroll
        for (int dt = 0; dt < 2; ++dt)
#pragma unroll
            for (int i = 0; i < 8; ++i) acc[dt][i] = (f32x4){0.f, 0.f, 0.f, 0.f};
#pragma unroll
        for (int ks = 0; ks < 4; ++ks) {
            bf16x8 af[2];
#pragma unroll
            for (int dt = 0; dt < 2; ++dt) { const int chl = 32 * wave + 8 * (r >> 2) + 4 * dt + (r & 3);
#pragma unroll
                for (int e = 0; e < 8; ++e) af[dt][e] = (short)*(const LAS unsigned short*)(vt + (ks * 32 + 8 * q + e) * VT_PITCH + chl * 2); }
#pragma unroll
            for (int i = 0; i < 8; ++i) { if (i < 4 && ks >= 2) continue;
                const bf16x8 bfr = *(const LAS bf16x8*)(wl + (16 * i + r) * WS_PITCH + (ks * 32 + 8 * q) * 2);
#pragma unroll
                for (int dt = 0; dt < 2; ++dt) acc[dt][i] = __builtin_amdgcn_mfma_f32_16x16x32_bf16(af[dt], bfr, acc[dt][i], 0, 0, 0); }
        }
        u32x4 uu2[4], gg2[4];
#pragma unroll
        for (int i = 0; i < 4; ++i) { const size_t o = ((size_t)it * 128 + 16 * (i + 4) + r) * 256 + 32 * wave + 8 * q; uu2[i] = __builtin_nontemporal_load((const u32x4*)(PROJ + OFF_U + o)); gg2[i] = __builtin_nontemporal_load((const u32x4*)(PROJ + OFF_GB + o)); }
#pragma unroll
        for (int i = 0; i < 8; ++i) { const int t = t0 + 16 * i + r; const int ch = cb + 32 * wave + 8 * q;
            const float bs = bsp[16 * i + r];
            float u8[8], g8[8], o[8];
            unpack8(i < 4 ? uu[i & 3] : uu2[i & 3], u8); unpack8(i < 4 ? gg[i & 3] : gg2[i & 3], g8);
#pragma unroll
            for (int e = 0; e < 8; e += 2) {
                const f32x2 gl = gelu_pk((f32x2){u8[e], u8[e + 1]});
                const f32x2 g2 = (f32x2){g8[e], g8[e + 1]}, z = g2 * (-1.4426950408889634f);
                const f32x2 d = (f32x2){__builtin_amdgcn_exp2f(z.x), __builtin_amdgcn_exp2f(z.y)} + 1.0f;
                const f32x2 sil = g2 * (f32x2){__builtin_amdgcn_rcpf(d.x), __builtin_amdgcn_rcpf(d.y)};
                const f32x2 r2 = gl * ((f32x2){acc[e >> 2][i][e & 3], acc[e >> 2][i][(e & 3) + 1]} + bs) * sil;
                o[e] = r2.x; o[e + 1] = r2.y; }
            *(u32x4*)(MIXED + ((size_t)((t >> 8) * 128 + ((4096 + ch) >> 6)) * 256 + (t & 255)) * 64 + (ch & 63)) = pack8(o);
            __builtin_amdgcn_sched_barrier(0); }
        if (has_next && tid < 128) statbuf[(par ^ 1) * 128 + tid] = stn;
    }
}

__device__ __forceinline__ void scan1_item(const Params& p, int it, int lane) {
    unsigned char* ws = p.ws;
    const unsigned* LOGA = (const unsigned*)(ws + WS_LOGA); const unsigned* INP = (const unsigned*)(ws + WS_INP);
    float* PP = (float*)(ws + WS_P); float* HE = (float*)(ws + WS_HEND);
    {
        const int k = it >> 5, s = it & 31; const size_t base = (size_t)it * (128 * 64) + lane;
        float h0 = 0.f, h1 = 0.f, l0 = 0.f, l1 = 0.f;
#pragma unroll 1
        for (int tb = 0; tb < 128; tb += 16) {
            unsigned la[16], ip[16];
#pragma unroll
            for (int i = 0; i < 16; ++i) { la[i] = LOGA[base + (size_t)(tb + i) * 64]; ip[i] = INP[base + (size_t)(tb + i) * 64]; }
#pragma unroll
            for (int i = 0; i < 16; ++i) { const float a0 = bflo(la[i]), a1 = bfhi(la[i]); l0 += a0; l1 += a1;
                h0 = __builtin_amdgcn_exp2f(1.4426950408889634f * a0) * h0 + bflo(ip[i]); h1 = __builtin_amdgcn_exp2f(1.4426950408889634f * a1) * h1 + bfhi(ip[i]); }
        }
        const int c = s * 128 + lane * 2;
        *(f32x2*)(PP + (size_t)k * WA + c) = (f32x2){__builtin_amdgcn_exp2f(1.4426950408889634f * l0), __builtin_amdgcn_exp2f(1.4426950408889634f * l1)};
        *(f32x2*)(HE + (size_t)k * WA + c) = (f32x2){h0, h1};
    }
}
__device__ __forceinline__ void scan1_phase(const Params& p, int gw, int NGW, int lane) { for (int it = gw; it < 64 * 32; it += NGW) scan1_item(p, it, lane); }
__device__ __forceinline__ void scan2_phase(const Params& p, int gw, int NGW, int lane) {
    unsigned char* ws = p.ws;
    const unsigned* LOGA = (const unsigned*)(ws + WS_LOGA); const unsigned* INP = (const unsigned*)(ws + WS_INP); const unsigned* PROJ = (const unsigned*)(ws + WS_PROJ);
    const float* PP = (const float*)(ws + WS_P); const float* HE = (const float*)(ws + WS_HEND); unsigned* MIXED = (unsigned*)(ws + WS_MIXED);
    for (int it = gw; it < 64 * 32; it += NGW) {
        const int k = it >> 5, s = it & 31; const int c = s * 128 + lane * 2;
        float h0 = 0.f, h1 = 0.f;
        for (int kb = 0; kb < k; kb += 16) { f32x2 pp[16], he[16];
#pragma unroll
            for (int j = 0; j < 16; ++j) { const int kk = (kb + j) & 63; pp[j] = *(const f32x2*)(PP + (size_t)kk * WA + c); he[j] = *(const f32x2*)(HE + (size_t)kk * WA + c); }
#pragma unroll
            for (int j = 0; j < 16; ++j) { const bool on = (kb + j) < k; const float p0 = on ? pp[j].x : 1.f, p1 = on ? pp[j].y : 1.f, e0 = on ? he[j].x : 0.f, e1 = on ? he[j].y : 0.f; h0 = p0 * h0 + e0; h1 = p1 * h1 + e1; } }
        const size_t base = (size_t)it * (128 * 64) + lane;
#pragma unroll 1
        for (int tb = 0; tb < 128; tb += 16) {
            unsigned la[16], ip[16], ga[16];
#pragma unroll
            for (int i = 0; i < 16; ++i) { la[i] = __builtin_nontemporal_load(LOGA + base + (size_t)(tb + i) * 64); ip[i] = __builtin_nontemporal_load(INP + base + (size_t)(tb + i) * 64);
                ga[i] = __builtin_nontemporal_load(PROJ + OFF_GA / 2 + base + (size_t)(tb + i) * 64); }
#pragma unroll
            for (int i = 0; i < 16; ++i) { const float a0 = bflo(la[i]), a1 = bfhi(la[i]);
                h0 = __builtin_amdgcn_exp2f(1.4426950408889634f * a0) * h0 + bflo(ip[i]); h1 = __builtin_amdgcn_exp2f(1.4426950408889634f * a1) * h1 + bfhi(ip[i]);
                { const int t = k * 128 + tb + i; MIXED[((size_t)((t >> 8) * 128 + 2 * s + (lane >> 5)) * 256 + (t & 255)) * 32 + (lane & 31)] = pk2(h0 * silu_f(bflo(ga[i])), h1 * silu_f(bfhi(ga[i]))); } }
        }
    }
}

__device__ __forceinline__ void final_phase(const Params& p, int gw, int NGW, int lane) {
    const float* SS = (const float*)(p.ws + WS_SS);
    for (int row = gw; row < SEQ; row += NGW) {
        const float ss = wave_sum(SS[(size_t)row * 64 + lane]);
        const float rstd = 1.0f / sqrtf(ss * (1.0f / DM) + EPS);
        f32x4* xr = (f32x4*)(p.out + (size_t)row * DM) + lane; const f32x4* gr = (const f32x4*)p.final_g + lane;
        f32x4 v[16];
#pragma unroll
        for (int j = 0; j < 16; ++j) v[j] = xr[64 * j];
#pragma unroll
        for (int j = 0; j < 16; ++j) { const f32x4 g = gr[64 * j]; xr[64 * j] = v[j] * rstd * g; }
    }
}

#define XB_TMO      128
#define XB_XCNT(j)  (256  + 64 * (j))
#define XB_XSUB(j)  (1280 + 64 * (j))
#define XB_XGEN(j)  (2304 + 64 * (j))
#define XB_TOP      3328
#define XB_TOPGEN   3392
#define XB_SPIN_CAP (1u << 20)
__device__ __forceinline__ unsigned xb_ld(unsigned* p)              { return __hip_atomic_load(p, __ATOMIC_RELAXED, __HIP_MEMORY_SCOPE_AGENT); }
__device__ __forceinline__ unsigned xb_add(unsigned* p, unsigned v) { return __hip_atomic_fetch_add(p, v, __ATOMIC_RELAXED, __HIP_MEMORY_SCOPE_AGENT); }
__device__ __forceinline__ unsigned xb_xcc_id() { return (unsigned)__builtin_amdgcn_s_getreg((3 << 11) | 20) & 0xFu; }
#define XB_SPIN(cond, bar) do { unsigned _sp = 0; while (cond) { __builtin_amdgcn_s_sleep(1); \
    if ((++_sp & 255u) == 0u) { if (xb_ld(&(bar)[XB_TMO])) break; if (_sp > XB_SPIN_CAP) { atomicAdd(&(bar)[XB_TMO], 1u); break; } } } } while (0)
struct XcdBarrier { unsigned* bar; unsigned x; volatile LAS unsigned* st; unsigned total; };
__device__ __forceinline__ XcdBarrier xcd_barrier_post(unsigned* bar, volatile LAS unsigned* st, unsigned total) {
    XcdBarrier b; b.bar = bar; b.x = xb_xcc_id(); b.st = st; b.total = total;
    if (threadIdx.x == 0) (void)xb_add(&bar[XB_XCNT(b.x)], 1u);
    return b;
}
__device__ __forceinline__ void xcd_barrier_complete(unsigned* bar, unsigned x, unsigned& nloc, unsigned& nx, unsigned G) {
    unsigned sum, cnt, mine, sp = 0u;
    for (;;) {
        sum = 0u; cnt = 0u; mine = 0u;
#pragma unroll
        for (unsigned j = 0; j < 16; ++j) { const unsigned c = xb_ld(&bar[XB_XCNT(j)]); sum += c; cnt += (c > 0u) ? 1u : 0u; mine = (j == x) ? c : mine; }
        if (sum == G) break;
        __builtin_amdgcn_s_sleep(1);
        if ((++sp & 255u) == 0u) { if (xb_ld(&bar[XB_TMO])) break; if (sp > XB_SPIN_CAP) { atomicAdd(&bar[XB_TMO], 1u); break; } }
    }
    nloc = mine > 0u ? mine : 1u; nx = cnt > 0u ? cnt : 1u;
}
__device__ __forceinline__ void xcd_barrier(const XcdBarrier& b) {
    asm volatile("s_waitcnt vmcnt(0)" ::: "memory");
    __syncthreads();
    if (threadIdx.x == 0) {
        unsigned* bar = b.bar;
        __builtin_amdgcn_s_waitcnt(0);
        unsigned nloc = b.st[0], nx = b.st[1];
        if (nloc == 0u) { xcd_barrier_complete(bar, b.x, nloc, nx, b.total); b.st[0] = nloc; b.st[1] = nx; }
        const unsigned old = xb_add(&bar[XB_XSUB(b.x)], 1u);
        const unsigned gen = old / nloc;
        if (old + 1u == (gen + 1u) * nloc) {
            __builtin_amdgcn_fence(__ATOMIC_RELEASE, "agent");
            asm volatile("s_waitcnt vmcnt(0)" ::: "memory");
            const unsigned og = xb_add(&bar[XB_TOP], 1u);
            const unsigned tg = og / nx;
            if (og + 1u == (tg + 1u) * nx) xb_add(&bar[XB_TOPGEN], 1u);
            else XB_SPIN(xb_ld(&bar[XB_TOPGEN]) == tg, bar);
            __builtin_amdgcn_fence(__ATOMIC_ACQUIRE, "agent");
            xb_add(&bar[XB_XGEN(b.x)], 1u);
            asm volatile("s_waitcnt vmcnt(0)" ::: "memory");
        } else {
            XB_SPIN(xb_ld(&bar[XB_XGEN(b.x)]) == gen, bar);
            __builtin_amdgcn_fence(__ATOMIC_ACQUIRE, "agent");
            asm volatile("s_waitcnt vmcnt(0)" ::: "memory");
        }
    }
    __syncthreads();
}

__global__ void __launch_bounds__(NTHREADS, 2) fwd_megakernel(Params p) {
    extern __shared__ __attribute__((aligned(16))) unsigned char lds_raw[];
    LAS unsigned char* lds = (LAS unsigned char*)lds_raw;
    cg::grid_group grid = cg::this_grid();
    const int tid = threadIdx.x, lane = tid & 63, wave = __builtin_amdgcn_readfirstlane(tid >> 6);
    const int G = gridDim.x, bid = blockIdx.x, gw = bid * NWAVES + wave, NGW = G * NWAVES;
    unsigned char* ws = p.ws;
    const int lo = p.ph_lo, hi = p.ph_hi;
#define IN(k) (lo <= (k) && (k) < hi)
    volatile LAS unsigned* xbst = (volatile LAS unsigned*)(lds + LDS_BYTES - 16);
    if (tid == 0) { xbst[0] = 0u; xbst[1] = 0u; xbst[2] = 0u; xbst[3] = 0u; }
    __syncthreads();
    const XcdBarrier xbar = xcd_barrier_post((unsigned*)(ws + WS_BAR), xbst, (unsigned)G);
    const bool split_in = (G == 256);
    XcdBarrier tbar = xbar;
    if (split_in) tbar = xcd_barrier_post((unsigned*)(ws + WS_BAR) + 8192 + 4096 * (bid & 1), xbst + 2, (unsigned)(G / 2));
    if (lo < 0) grid.sync();
#define SYNC(k) do { if (IN(k) && IN((k) + 1)) xcd_barrier(xbar); } while (0)

    if (IN(0)) phase0(p, lds, gw, NGW, wave, lane, split_in ? 224 : 320);
    SYNC(0);
    if (IN(1)) {
        const int team = bid & 1, tb = bid >> 1, ntb = (G + 1 - team) >> 1;
        constexpr int I_OUT = 128 * 64;
        bf16_t* WOUTT = (bf16_t*)(ws + WS_WOUTT);
        if (team == 1) {
            if (split_in) { transpose_slice<false>(p.w_in, INC, (bf16_t*)(ws + WS_WINT), 64, 96, 224, lds, 0, 64 * 96, tb * NWAVES + wave, ntb * NWAVES, wave, lane); xcd_barrier(tbar); }
            transpose_slice<true>(p.w_out, DM, WOUTT, 128, 64, 0, lds, 0, split_in ? 3 * I_OUT / 8 : I_OUT / 2, tb * NWAVES + wave, ntb * NWAVES, wave, lane); __syncthreads();
        }
        ProbIn P{(const char*)(ws + WS_HN), (const char*)(ws + WS_WINT), DM, 64, DM / 64, 128, 32768};
        pg8::StaticOrder S; S.init(SEQ / 256, INC / 256, G, bid);
        EpiProj E{(bf16_t*)(ws + WS_PROJ), (float*)(ws + WS_LNS)};
        pg8::gemm_phase<true>(lds, P, S, E);
        if (team == 0) {
            if (split_in) { xcd_barrier(tbar); conv_items(p, tb * NWAVES + wave, ntb * NWAVES, lane); }
            __syncthreads(); transpose_slice<true>(p.w_out, DM, WOUTT, 128, 64, 0, lds, split_in ? 3 * I_OUT / 8 : I_OUT / 2, I_OUT, tb * NWAVES + wave, ntb * NWAVES, wave, lane); }
    }
    SYNC(1);
    if (!split_in) { if (IN(2)) conv_items(p, gw, NGW, lane); SYNC(2); }
    if (IN(3)) {
        ProbGate P{(const char*)(ws + WS_XC), (const char*)(ws + WS_WGT), WA, 256, 4, 128, 128};
        pg8::StaticOrder S; S.init(SEQ / 256, 32, G, bid);
        EpiGate E{(const bf16_t*)(ws + WS_XC), p.b_gate_a, p.b_gate_x, (const float*)(ws + WS_SP8), (bf16_t*)(ws + WS_LOGA), (bf16_t*)(ws + WS_INP)};
        pg8::gemm_phase<true>(lds, P, S, E);
        asm volatile("s_waitcnt vmcnt(0)" ::: "memory"); __syncthreads();
        { Unit u; for (int j = wave; S.next(j >> 1, u); j += NWAVES) scan1_item(p, (2 * u.pm + (j & 1)) * 32 + u.pn, lane); }
        stats_rows(p, gw, NGW, lane);
    }
    SYNC(3);
    if (IN(5)) { scan2_phase(p, gw, NGW, lane); spatial_phase(p, lds, bid, G, tid, wave, lane); }
    if (IN(5) && IN(6)) xcd_barrier(xbar);
    const bool fuse_final = (G == 256);
    if (IN(6)) {
        ProbOut P{(const char*)(ws + WS_MIXED), (const char*)(ws + WS_WOUTT), 64, 64, MIXW / 64, 32768, 32768};
        if (fuse_final) {
            OrderPanel S{bid};
            EpiOutFused E{p.x, p.out, (float*)(ws + WS_SS), (unsigned*)(ws + WS_BAR) + 4096, p.final_g};
            pg8::gemm_phase<false>(lds, P, S, E);
        } else {
            pg8::StaticOrder S; S.init(SEQ / 256, DM / 256, G, bid);
            EpiOut E{p.x, p.out, (float*)(ws + WS_SS)};
            pg8::gemm_phase<false>(lds, P, S, E);
        }
    }
    if (!fuse_final) {
        SYNC(6);
        if (IN(7)) final_phase(p, gw, NGW, lane);
    }
#undef IN
#undef SYNC
}

extern "C" void kernel_launch(void* const* d_in, const int* in_sizes, int n_in, void* d_out, int out_size, void* d_ws, size_t ws_size, hipStream_t stream) {
    static int grid_blocks = 0;
    if (!grid_blocks) {
        int dev = 0, cus = 0, per_cu = 0;
        hipGetDevice(&dev);
        hipDeviceGetAttribute(&cus, hipDeviceAttributeMultiprocessorCount, dev);
        hipFuncSetAttribute((const void*)fwd_megakernel, hipFuncAttributeMaxDynamicSharedMemorySize, LDS_BYTES);
        hipOccupancyMaxActiveBlocksPerMultiprocessor(&per_cu, (const void*)fwd_megakernel, NTHREADS, LDS_BYTES);
        if (per_cu < 1) { fprintf(stderr, "occupancy query says %d blocks per CU\n", per_cu); per_cu = 1; }
        (void)hipGetLastError();
        grid_blocks = cus * 1;
        if (ws_size < WS_END) fprintf(stderr, "workspace too small: %zu < %zu\n", ws_size, (size_t)WS_END);
    }
    Params p{};
    p.x = (const float*)d_in[0]; p.norm_g = (const float*)d_in[1]; p.w_in = (const float*)d_in[2]; p.conv_w = (const float*)d_in[3]; p.conv_b = (const float*)d_in[4];
    p.w_gate_a = (const float*)d_in[5]; p.b_gate_a = (const float*)d_in[6]; p.w_gate_x = (const float*)d_in[7]; p.b_gate_x = (const float*)d_in[8]; p.lru_lambda = (const float*)d_in[9];
    p.ln_v_g = (const float*)d_in[10]; p.ln_v_b = (const float*)d_in[11]; p.w_spatial = (const float*)d_in[12]; p.b_spatial = (const float*)d_in[13]; p.w_out = (const float*)d_in[14]; p.final_g = (const float*)d_in[15];
    p.out = (float*)d_out; p.ws = (unsigned char*)d_ws; p.ph_lo = 0; p.ph_hi = 8;
    hipMemsetAsync((char*)d_ws + WS_BAR, 0, BAR_BYTES, stream);
    void* args[] = {&p};
    hipError_t e = hipLaunchCooperativeKernel((const void*)fwd_megakernel, dim3(grid_blocks), dim3(NTHREADS), args, LDS_BYTES, stream);
    if (e != hipSuccess) fprintf(stderr, "cooperative launch failed: %s (grid %d)\n", hipGetErrorString(e), grid_blocks);
}
```
